# Optimizing an MI355X kernel written in HIP

```python
import math
import jax
import jax.numpy as jnp
from jax import lax
import numpy as np

D_MODEL = 1024
BATCH = 8
SEQ = 4096
DEPTH = 1

GRID_W = 64
CTX_LEN = 256
F_GROUPS = 4
F_GROUP_DIM = 128
F_WIDTH = F_GROUPS * F_GROUP_DIM
DN_HEADS = 8
DN_HEAD_DIM = 128
DN_WIDTH = DN_HEADS * DN_HEAD_DIM
CONV_K = 3
CHUNK = 64
N_DIR = 2
IN_SPLITS = (F_WIDTH, F_WIDTH, 3 * DN_WIDTH, DN_WIDTH, N_DIR * DN_HEADS, N_DIR * DN_HEADS, D_MODEL, D_MODEL)
IN_COLS = sum(IN_SPLITS)
IN_OFFSETS = tuple(int(o) for o in np.cumsum(IN_SPLITS)[:-1])
DEEPNORM_ALPHA = (2 * DEPTH) ** 0.25
DEEPNORM_BETA = (8 * DEPTH) ** -0.25
EPS = 1e-6

kernel_name = 'hybrid_fourier_deltanet_dit'


def layer_norm(x):
    xf = x.astype(jnp.float32)
    mu = jnp.mean(xf, axis=-1, keepdims=True)
    var = jnp.mean(jnp.square(xf - mu), axis=-1, keepdims=True)
    return ((xf - mu) * lax.rsqrt(var + EPS)).astype(x.dtype)


def l2_normalize(x):
    xf = x.astype(jnp.float32)
    return xf * lax.rsqrt(jnp.sum(xf * xf, axis=-1, keepdims=True) + EPS)


def sincos_2d(rows, cols, dim, dtype):
    quarter = dim // 4
    omega = 1.0 / (10000.0 ** (jnp.arange(quarter, dtype=jnp.float32) / quarter))
    pr = jnp.arange(rows, dtype=jnp.float32)[:, None] * omega
    pc = jnp.arange(cols, dtype=jnp.float32)[:, None] * omega
    er = jnp.concatenate([jnp.sin(pr), jnp.cos(pr)], axis=-1)
    ec = jnp.concatenate([jnp.sin(pc), jnp.cos(pc)], axis=-1)
    pe = jnp.concatenate([jnp.broadcast_to(er[:, None, :], (rows, cols, dim // 2)),
                          jnp.broadcast_to(ec[None, :, :], (rows, cols, dim // 2))], axis=-1)
    return pe.reshape(rows * cols, dim).astype(dtype)


def centred_depthwise_conv(x, w):
    n = x.shape[1]
    pad = w.shape[0] // 2
    xp = jnp.pad(x, ((0, 0), (pad, pad), (0, 0)))
    out = xp[:, 0:n] * w[0]
    for j in range(1, w.shape[0]):
        out = out + xp[:, j:j + n] * w[j]
    return out


def gated_delta_chunked(q, k, v, beta, g, s0):
    f32 = jnp.float32
    bsz, n, h, dk = q.shape
    dv = v.shape[-1]
    nc = n // CHUNK

    def to_chunks(t):
        t = t.astype(f32).reshape((bsz, nc, CHUNK) + t.shape[2:])
        return jnp.moveaxis(t, 3, 1)

    q = to_chunks(q) * (dk ** -0.5)
    k = to_chunks(k)
    v = to_chunks(v)
    beta = to_chunks(beta)
    gc = jnp.cumsum(to_chunks(g), axis=-1)
    idx = jnp.arange(CHUNK)
    tril = idx[:, None] >= idx[None, :]
    strict = idx[:, None] > idx[None, :]
    decay = jnp.exp(jnp.where(tril, gc[..., :, None] - gc[..., None, :], -jnp.inf))
    kb = k * beta[..., None]
    a_mat = jnp.where(strict, jnp.einsum('bhnid,bhnjd->bhnij', kb, k) * decay, 0.0) + jnp.eye(CHUNK, dtype=f32)
    rhs = jnp.concatenate([v * beta[..., None], kb * jnp.exp(gc)[..., None]], axis=-1)
    sol = lax.linalg.triangular_solve(a_mat, rhs, left_side=True, lower=True, unit_diagonal=True)
    u, w = sol[..., :dv], sol[..., dv:]
    qk = jnp.where(tril, jnp.einsum('bhnid,bhnjd->bhnij', q, k) * decay, 0.0)

    def step(s, xs):
        q_c, k_c, u_c, w_c, qk_c, gc_c = xs
        v_new = u_c - jnp.einsum('bhcd,bhde->bhce', w_c, s)
        o_c = (jnp.einsum('bhcd,bhde->bhce', q_c * jnp.exp(gc_c)[..., None], s)
               + jnp.einsum('bhij,bhje->bhie', qk_c, v_new))
        g_last = gc_c[..., -1]
        k_dec = k_c * jnp.exp(g_last[..., None] - gc_c)[..., None]
        s = s * jnp.exp(g_last)[..., None, None] + jnp.einsum('bhcd,bhce->bhde', k_dec, v_new)
        return s, o_c

    xs = tuple(jnp.moveaxis(t, 2, 0) for t in (q, k, u, w, qk, gc))
    s_final, o = lax.scan(step, s0.astype(f32), xs)
    o = jnp.transpose(o, (1, 0, 3, 2, 4)).reshape(bsz, n, h, dv)
    return o, s_final


def deltanet_branch(qkv, dn_gate, beta_raw, decay_raw, conv_w, a_log, dt_bias, norm_w, w_dn_out, s0_f, s0_b):
    bsz, n, _ = qkv.shape
    qkv = jax.nn.silu(centred_depthwise_conv(qkv, conv_w))
    q, k, v = jnp.split(qkv, 3, axis=-1)
    q = l2_normalize(q.reshape(bsz, n, DN_HEADS, DN_HEAD_DIM))
    k = l2_normalize(k.reshape(bsz, n, DN_HEADS, DN_HEAD_DIM))
    v = v.reshape(bsz, n, DN_HEADS, DN_HEAD_DIM)
    beta = jax.nn.sigmoid(beta_raw.astype(jnp.float32)).reshape(bsz, n, N_DIR, DN_HEADS)
    g = -jnp.exp(a_log.astype(jnp.float32)) * jax.nn.softplus(
        decay_raw.astype(jnp.float32).reshape(bsz, n, N_DIR, DN_HEADS) + dt_bias.astype(jnp.float32))
    o_f, s_f = gated_delta_chunked(q, k, v, beta[:, :, 0], g[:, :, 0], s0_f)
    flip = lambda t: jnp.flip(t, axis=1)
    o_b, s_b = gated_delta_chunked(flip(q), flip(k), flip(v), flip(beta[:, :, 1]), flip(g[:, :, 1]), s0_b)
    o = o_f + flip(o_b)
    o = o * lax.rsqrt(jnp.mean(o * o, axis=-1, keepdims=True) + EPS) * norm_w.astype(jnp.float32)
    o = o.astype(qkv.dtype).reshape(bsz, n, DN_WIDTH) * jax.nn.silu(dn_gate)
    return o @ w_dn_out, s_f, s_b


def fourier_branch(f_val, f_gate, w_fmix, w_f_out):
    bsz, n, _ = f_val.shape
    u = f_val.astype(jnp.float32).reshape(bsz, n, F_GROUPS, F_GROUP_DIM)
    mixed = jnp.fft.fft2(u, axes=(1, 3), norm='ortho').real.astype(f_val.dtype)
    mixed = jnp.einsum('bngc,gcd->bngd', mixed, w_fmix).reshape(bsz, n, F_WIDTH)
    return (mixed * jax.nn.silu(f_gate)) @ w_f_out


def merge_branches(r_f, r_d, y_f, y_d, w_out):
    return (jax.nn.sigmoid(r_f) * y_f + jax.nn.sigmoid(r_d) * y_d) @ w_out


def setup_inputs(seed: int = 0) -> dict:
    key = jax.random.key(seed)
    ks = jax.random.split(key, 17)
    f32 = jnp.float32

    def nrm(k, shape, scale):
        return jax.random.normal(k, shape, f32) * scale

    x = nrm(ks[0], (BATCH, SEQ, D_MODEL), 1.0)
    c = nrm(ks[1], (BATCH, D_MODEL), 1.0)
    ctx = nrm(ks[2], (BATCH, CTX_LEN, D_MODEL), 1.0)
    c_ctx = nrm(ks[3], (D_MODEL,), 1.0)
    w_mod = nrm(ks[4], (DEPTH, D_MODEL, 3 * D_MODEL), 0.5 * D_MODEL ** -0.5)
    b_mod = nrm(ks[5], (DEPTH, 3 * D_MODEL), 0.02)
    w_in = nrm(ks[6], (DEPTH, D_MODEL, IN_COLS), D_MODEL ** -0.5)
    conv_w = nrm(ks[7], (DEPTH, CONV_K, 3 * DN_WIDTH), CONV_K ** -0.5)
    a_log = jnp.log(jax.random.uniform(ks[8], (DEPTH, N_DIR, DN_HEADS), f32, 1.0, 16.0))
    dt = jnp.exp(jax.random.uniform(ks[9], (DEPTH, N_DIR, DN_HEADS), f32, math.log(1e-3), math.log(1e-1)))
    dt_bias = dt + jnp.log(-jnp.expm1(-dt))
    dn_norm_w = 1.0 + nrm(ks[10], (DEPTH, DN_HEAD_DIM), 0.02)
    w_dn_out = nrm(ks[11], (DEPTH, DN_WIDTH, D_MODEL), DEEPNORM_BETA * DN_WIDTH ** -0.5)
    w_fmix = nrm(ks[12], (DEPTH, F_GROUPS, F_GROUP_DIM, F_GROUP_DIM), F_GROUP_DIM ** -0.5)
    w_f_out = nrm(ks[13], (DEPTH, F_WIDTH, D_MODEL), DEEPNORM_BETA * F_WIDTH ** -0.5)
    w_out = nrm(ks[14], (DEPTH, D_MODEL, D_MODEL), DEEPNORM_BETA * D_MODEL ** -0.5)
    ln_g = 1.0 + nrm(ks[15], (DEPTH, D_MODEL), 0.02)
    ln_b = nrm(ks[16], (DEPTH, D_MODEL), 0.02)
    return {'x': x, 'c': c, 'ctx': ctx, 'c_ctx': c_ctx, 'w_mod': w_mod, 'b_mod': b_mod,
            'w_in': w_in, 'conv_w': conv_w, 'a_log': a_log, 'dt_bias': dt_bias,
            'dn_norm_w': dn_norm_w, 'w_dn_out': w_dn_out, 'w_fmix': w_fmix, 'w_f_out': w_f_out,
            'w_out': w_out, 'ln_g': ln_g, 'ln_b': ln_b}


def reference(x, c, ctx, c_ctx, w_mod, b_mod, w_in, conv_w, a_log, dt_bias, dn_norm_w,
              w_dn_out, w_fmix, w_f_out, w_out, ln_g, ln_b):
    n_lat = x.shape[1]
    rows = n_lat // GRID_W
    x = x + sincos_2d(rows, GRID_W, D_MODEL, x.dtype)[None]
    for l in range(DEPTH):
        mod_x = jax.nn.silu(c) @ w_mod[l] + b_mod[l]
        mod_c = jax.nn.silu(c_ctx) @ w_mod[l] + b_mod[l]
        shift_x, scale_x, gate_x = jnp.split(mod_x[:, None, :], 3, axis=-1)
        shift_c, scale_c, gate_c = jnp.split(mod_c, 3, axis=-1)
        h_x = layer_norm(x) * (1.0 + scale_x) + shift_x
        h_c = layer_norm(ctx) * (1.0 + scale_c) + shift_c
        p_x = jnp.split(h_x @ w_in[l], IN_OFFSETS, axis=-1)
        p_c = jnp.split(h_c @ w_in[l], IN_OFFSETS, axis=-1)
        zero_state = jnp.zeros((ctx.shape[0], DN_HEADS, DN_HEAD_DIM, DN_HEAD_DIM), jnp.float32)
        y_dn_c, s_f, s_b = deltanet_branch(p_c[2], p_c[3], p_c[4], p_c[5], conv_w[l], a_log[l], dt_bias[l],
                                           dn_norm_w[l], w_dn_out[l], zero_state, zero_state)
        y_dn_x, _, _ = deltanet_branch(p_x[2], p_x[3], p_x[4], p_x[5], conv_w[l], a_log[l], dt_bias[l],
                                       dn_norm_w[l], w_dn_out[l], s_f, s_b)
        y_f_x = fourier_branch(p_x[0], p_x[1], w_fmix[l], w_f_out[l])
        out_x = merge_branches(p_x[6], p_x[7], y_f_x, y_dn_x, w_out[l])
        x_next = layer_norm(DEEPNORM_ALPHA * x + gate_x * out_x) * ln_g[l] + ln_b[l]
        if l + 1 < DEPTH:
            y_f_c = fourier_branch(p_c[0], p_c[1], w_fmix[l], w_f_out[l])
            out_c = merge_branches(p_c[6], p_c[7], y_f_c, y_dn_c, w_out[l])
            ctx = layer_norm(DEEPNORM_ALPHA * ctx + gate_c * out_c) * ln_g[l] + ln_b[l]
        x = x_next
    return x
```

```cpp
#include <hip/hip_runtime.h>
#include <hip/hip_cooperative_groups.h>
#include <cstdio>
namespace cg = cooperative_groups;

#ifndef MK_MULTI
#define MK_MULTI 0
#endif

typedef unsigned short u16;
using bf16x8 = __attribute__((ext_vector_type(8))) short;
using f32x16 = __attribute__((ext_vector_type(16))) float;
using u32x4 = __attribute__((ext_vector_type(4))) unsigned;
using u32x2 = __attribute__((ext_vector_type(2))) unsigned;
typedef __bf16 bf2_t __attribute__((ext_vector_type(2)));
typedef float f2_t __attribute__((ext_vector_type(2)));
#define DI __device__ __forceinline__
#define MFMA(a, b, c) __builtin_amdgcn_mfma_f32_32x32x16_bf16((a), (b), (c), 0, 0, 0)

constexpr int NLAT = 32768;
constexpr int NROWS = 34816;
constexpr size_t MiB = 1u << 20;
constexpr size_t OFF_WT1 = 0;
constexpr size_t OFF_WFMIX = 16 * MiB;
constexpr size_t OFF_WFOUT = 17 * MiB;
constexpr size_t OFF_WDN = 18 * MiB;
constexpr size_t OFF_WOUT = 20 * MiB;
constexpr size_t OFF_POS = 22 * MiB;
constexpr size_t OFF_MOD = 23 * MiB;
constexpr size_t OFF_GL = 23 * MiB + 512 * 1024;
constexpr size_t OFF_STATE = 24 * MiB;
constexpr size_t OFF_BD = 32 * MiB;
constexpr size_t OFF_H = 37 * MiB;
constexpr size_t OFF_MIXED = 105 * MiB;
constexpr size_t OFF_QKV = 137 * MiB;
constexpr size_t OFF_OPBUF = 341 * MiB;
constexpr size_t OPBUF_SLOT = 72 * MiB;
constexpr size_t OFF_GATES = 137 * MiB;
constexpr size_t OFF_OD = 361 * MiB;
constexpr size_t OFF_MG = 425 * MiB;
constexpr size_t OFF_MERGED = 37 * MiB;
constexpr size_t WS_NEEDED = 485 * MiB;
constexpr int BLOB = 73728;
constexpr int SMEM_BYTES = 73728;
constexpr int NPHASE = 18;

struct Params {
  const float *x, *c, *ctx, *c_ctx, *w_mod, *b_mod, *w_in, *conv_w, *a_log, *dt_bias, *dn_norm_w, *w_dn_out, *w_fmix,
      *w_f_out, *w_out, *ln_g, *ln_b;
  float* out;
  char* ws;
  int phase_lo, phase_hi;
};

DI unsigned pk2(float a, float b) {
  f2_t v = {a, b};
  bf2_t r = __builtin_convertvector(v, bf2_t);
  return __builtin_bit_cast(unsigned, r);
}
DI u16 f2bf(float a) { return (u16)(pk2(a, 0.f) & 0xffffu); }
DI float bf2f(u16 v) { return __uint_as_float(((unsigned)v) << 16); }
DI float bflo(unsigned v) { return __uint_as_float(v << 16); }
DI float bfhi(unsigned v) { return __uint_as_float(v & 0xffff0000u); }
DI float silu_f(float x) { return x / (1.f + __expf(-x)); }
DI float sigm_f(float x) { return 1.f / (1.f + __expf(-x)); }
DI int tid() { int t = threadIdx.x; asm volatile("" : "+v"(t)); return t; }
DI int crow(int reg, int h) { return (reg & 3) + 8 * (reg >> 2) + 4 * h; }
DI bf16x8 pack_step(const f32x16& x, int s) {
  u32x4 p;
  p[0] = pk2(x[8 * s + 0], x[8 * s + 1]);
  p[1] = pk2(x[8 * s + 2], x[8 * s + 3]);
  p[2] = pk2(x[8 * s + 4], x[8 * s + 5]);
  p[3] = pk2(x[8 * s + 6], x[8 * s + 7]);
  return __builtin_bit_cast(bf16x8, p);
}
DI f32x16 zero16() {
  f32x16 z;
#pragma unroll
  for (int i = 0; i < 16; ++i) z[i] = 0.f;
  return z;
}
DI float wave_sum(float v) {
#pragma unroll
  for (int m = 32; m >= 1; m >>= 1) v += __shfl_xor(v, m);
  return v;
}

DI void gemm_mainloop(const u16* __restrict__ A, size_t lda, const u16* __restrict__ B, size_t ldb, int K,
                      f32x16 (&acc)[2][2], char* smem) {
  const int t = tid(), lane = t & 63, w = t >> 6, wm = w >> 1, wn = w & 1;
  const int lrow = t >> 3, lch = t & 7;
  const u16* ga = A + (size_t)lrow * lda + lch * 8;
  const u16* gb = B + (size_t)lrow * ldb + lch * 8;
  const int woff = lrow * 128 + ((lch ^ ((lrow >> 1) & 7)) * 16);
  const int fr = lane & 31, fh = lane >> 5, fsw = (fr >> 1) & 7;
  const int aoff = (wm * 64 + fr) * 128, boff = (wn * 64 + fr) * 128;
  u32x4 ra[4], rb[4];
  const int nk = K >> 6;
#pragma unroll
  for (int i = 0; i < 4; ++i) {
    ra[i] = *(const u32x4*)(ga + (size_t)(32 * i) * lda);
    rb[i] = *(const u32x4*)(gb + (size_t)(32 * i) * ldb);
  }
#pragma unroll
  for (int i = 0; i < 4; ++i) {
    *(u32x4*)(smem + woff + i * 4096) = ra[i];
    *(u32x4*)(smem + 16384 + woff + i * 4096) = rb[i];
  }
  __syncthreads();
#pragma unroll 1
  for (int kt = 0; kt < nk; ++kt) {
    const bool more = (kt + 1) < nk;
    if (more) {
      const int k0 = (kt + 1) << 6;
#pragma unroll
      for (int i = 0; i < 4; ++i) {
        ra[i] = *(const u32x4*)(ga + (size_t)(32 * i) * lda + k0);
        rb[i] = *(const u32x4*)(gb + (size_t)(32 * i) * ldb + k0);
      }
    }
    const char* sa = smem + (kt & 1) * 32768;
    const char* sb = sa + 16384;
#pragma unroll
    for (int s = 0; s < 4; ++s) {
      const int ph = ((2 * s + fh) ^ fsw) * 16;
      bf16x8 a0 = *(const bf16x8*)(sa + aoff + ph);
      bf16x8 a1 = *(const bf16x8*)(sa + aoff + 4096 + ph);
      bf16x8 b0 = *(const bf16x8*)(sb + boff + ph);
      bf16x8 b1 = *(const bf16x8*)(sb + boff + 4096 + ph);
      acc[0][0] = MFMA(a0, b0, acc[0][0]);
      acc[0][1] = MFMA(a0, b1, acc[0][1]);
      acc[1][0] = MFMA(a1, b0, acc[1][0]);
      acc[1][1] = MFMA(a1, b1, acc[1][1]);
      __builtin_amdgcn_sched_barrier(0);
    }
    if (more) {
      char* da = smem + ((kt + 1) & 1) * 32768;
#pragma unroll
      for (int i = 0; i < 4; ++i) {
        *(u32x4*)(da + woff + i * 4096) = ra[i];
        *(u32x4*)(da + 16384 + woff + i * 4096) = rb[i];
      }
    }
    __syncthreads();
  }
}

template <class F>
DI void stage_tile(f32x16 (&acc)[2][2], char* smem, F f) {
  const int t = tid(), lane = t & 63, w = t >> 6, wm = w >> 1, wn = w & 1;
  const int fr = lane & 31, fh = lane >> 5;
#pragma unroll
  for (int i = 0; i < 2; ++i)
#pragma unroll
    for (int j = 0; j < 2; ++j)
#pragma unroll
      for (int g = 0; g < 16; ++g) {
        const int row = wm * 64 + i * 32 + crow(g, fh);
        const int col = wn * 64 + j * 32 + fr;
        *(u16*)(smem + row * 272 + col * 2) = f2bf(f(acc[i][j][g], row, col));
      }
  __syncthreads();
}
DI u32x4 staged_piece(const char* smem, int p, int& row, int& c8) {
  const int id = tid() + 256 * p;
  row = id >> 4;
  c8 = (id & 15) * 8;
  return *(const u32x4*)(smem + row * 272 + c8 * 2);
}
template <class F>
DI void store_tile_bf16(f32x16 (&acc)[2][2], char* smem, u16* dst, size_t ldd, F f) {
  stage_tile(acc, smem, f);
#pragma unroll
  for (int p = 0; p < 8; ++p) {
    int row, c8;
    const u32x4 v = staged_piece(smem, p, row, c8);
    *(u32x4*)(dst + (size_t)row * ldd + c8) = v;
  }
  __syncthreads();
}
DI u32x4 mul_bf8(u32x4 a, u32x4 g) {
  u32x4 o;
#pragma unroll
  for (int e = 0; e < 4; ++e) o[e] = pk2(bflo(a[e]) * bflo(g[e]), bfhi(a[e]) * bfhi(g[e]));
  return o;
}

DI void zero_acc(f32x16 (&acc)[2][2]) {
  acc[0][0] = zero16(); acc[0][1] = zero16(); acc[1][0] = zero16(); acc[1][1] = zero16();
}

DI void transpose_task(const float* __restrict__ src, int ld, int col0, int k0, u16* dst, int ldd, char* smem) {
  float* ts = (float*)smem;
  const int t = tid();
  {
    const int c = t & 31, kr = t >> 5;
#pragma unroll
    for (int p = 0; p < 8; ++p) {
      const int kk = kr + 8 * p;
      ts[kk * 33 + c] = (col0 >= 0) ? src[(size_t)(k0 + kk) * ld + col0 + c] : 0.f;
    }
  }
  __syncthreads();
  {
    const int wr = t >> 3, kc = t & 7;
    u32x4 v;
#pragma unroll
    for (int e = 0; e < 4; ++e) v[e] = pk2(ts[(kc * 8 + 2 * e) * 33 + wr], ts[(kc * 8 + 2 * e + 1) * 33 + wr]);
    *(u32x4*)(dst + (size_t)wr * ldd + k0 + kc * 8) = v;
  }
  __syncthreads();
}

DI int wt1_srccol(int row) {
  if (row < 4096) return row;
  if (row < 4128) return 5120 + (row - 4096);
  if (row < 4224) return -1;
  if (row < 4736) return 512 + (row - 4224);
  if (row < 5760) return 4096 + (row - 4736);
  return 5152 + (row - 5760);
}

DI void phase_prep(const Params& P, char* smem) {
  const int t = tid();
  u16* WT1 = (u16*)(P.ws + OFF_WT1);
  constexpr int T_IN = 212 * 16;
  constexpr int T_FOUT = 32 * 8, T_DN = 32 * 16, T_OUT = 32 * 16, T_FMIX = 32, T_FOLD = 1024, T_TRIG = 512, T_POS = 32,
                T_MOD = 48;
  constexpr int B1 = T_IN, B2 = B1 + T_FOUT, B3 = B2 + T_DN, B4 = B3 + T_OUT, B5 = B4 + T_FMIX, B6 = B5 + T_FOLD,
                B7 = B6 + T_TRIG, B8 = B7 + T_POS, B9 = B8 + T_MOD;
  bool tab_built = false;
  for (int task = blockIdx.x; task < B9; task += gridDim.x) {
    if (task < B1) {
      const int rt = task >> 4, kt = task & 15;
      const int row0 = 1024 + rt * 32;
      transpose_task(P.w_in, 7200, wt1_srccol(row0), kt * 64, WT1 + (size_t)row0 * 1024, 1024, smem);
    } else if (task < B2) {
      const int id = task - B1, rt = id >> 3, kt = id & 7;
      transpose_task(P.w_f_out, 1024, rt * 32, kt * 64, (u16*)(P.ws + OFF_WFOUT) + (size_t)(rt * 32) * 512, 512, smem);
    } else if (task < B3) {
      const int id = task - B2, rt = id >> 4, kt = id & 15;
      transpose_task(P.w_dn_out, 1024, rt * 32, kt * 64, (u16*)(P.ws + OFF_WDN) + (size_t)(rt * 32) * 1024, 1024, smem);
    } else if (task < B4) {
      const int id = task - B3, rt = id >> 4, kt = id & 15;
      transpose_task(P.w_out, 1024, rt * 32, kt * 64, (u16*)(P.ws + OFF_WOUT) + (size_t)(rt * 32) * 1024, 1024, smem);
    } else if (task < B5) {
      const int id = task - B4, g = id >> 3, rt = (id >> 1) & 3, kt = id & 1;
      transpose_task(P.w_fmix + (size_t)g * 16384, 128, rt * 32, kt * 64,
                     (u16*)(P.ws + OFF_WFMIX) + (size_t)(g * 128 + rt * 32) * 128, 128, smem);
    } else if (task < B6) {
      const int id = task - B5, which = id >> 9, mblk = (id >> 4) & 31, dblk = id & 15;
      const int g = mblk >> 3;
      const int d0 = dblk * 64;
      float* Wsm = (float*)smem;
      float* tab = Wsm + 64 * 129;
      for (int idx = t; idx < 64 * 128; idx += 256) {
        const int d = idx >> 7, c = idx & 127;
        Wsm[d * 129 + c] = P.w_in[(size_t)(d0 + d) * 7200 + g * 128 + c];
      }
      if (t < 128) tab[t] = which ? sinpif((float)t * (1.f / 64.f)) : cospif((float)t * (1.f / 64.f));
      __syncthreads();
      const int d = t & 63, mg = t >> 6;
#pragma unroll 1
      for (int e = 0; e < 4; ++e) {
        const int m = (mblk & 7) * 16 + mg * 4 + e;
        float s = 0.f;
        for (int c = 0; c < 128; ++c) s += Wsm[d * 129 + c] * tab[(m * c) & 127];
        WT1[(size_t)(which * 512 + g * 128 + m) * 1024 + d0 + d] = f2bf(s);
      }
      __syncthreads();
    } else if (task < B7) {
      float* tab = (float*)(smem + 40960);
      if (!tab_built) {
        for (int j = t; j < 4096; j += 256) tab[j] = cospif((float)j * (1.f / 2048.f));
        tab_built = true;
        __syncthreads();
      }
      u16* TRIG = (u16*)P.out + (size_t)4096 * 8192;
      const int id = task - B6;
      for (int rr = 0; rr < 8; ++rr) {
        const int k = id * 8 + rr;
#pragma unroll
        for (int p = 0; p < 4; ++p) {
          const int chunk = t + 256 * p;
          const int n0 = chunk * 8;
          const int part = n0 >= 4096, nb = n0 & 4095;
          float v[8];
#pragma unroll
          for (int e = 0; e < 8; ++e) {
            const int idx = (k * (nb + e)) & 4095;
            v[e] = part ? -tab[(idx - 1024) & 4095] : tab[idx];
          }
          u32x4 o;
#pragma unroll
          for (int e = 0; e < 4; ++e) o[e] = pk2(v[2 * e], v[2 * e + 1]);
          *(u32x4*)(TRIG + (size_t)k * 8192 + n0) = o;
        }
      }
    } else if (task < B8) {
      const int id = task - B7;
      float* POS = (float*)(P.ws + OFF_POS);
#pragma unroll 1
      for (int q = 0; q < 8; ++q) {
        const int e = id * 2048 + q * 256 + t;
        const int p = (e >> 9) & 63, d = e & 511, i = d & 255;
        const float omega = 1.0f / powf(10000.0f, (float)i * (1.f / 256.f));
        const float a = (float)p * omega;
        POS[e] = (d < 256) ? sinf(a) : cosf(a);
      }
    } else {
      const int id = task - B8;
      __syncthreads();
      float* sc = (float*)smem;
      for (int idx = t; idx < 9 * 1024; idx += 256) {
        const int v = idx >> 10, k = idx & 1023;
        const float cv = (v < 8) ? P.c[v * 1024 + k] : P.c_ctx[k];
        sc[idx] = silu_f(cv);
      }
      __syncthreads();
      const int col = id * 64 + (t & 63), part = t >> 6;
      float a[9];
#pragma unroll
      for (int v = 0; v < 9; ++v) a[v] = 0.f;
      for (int k = part * 256; k < part * 256 + 256; ++k) {
        const float wv = P.w_mod[(size_t)k * 3072 + col];
#pragma unroll
        for (int v = 0; v < 9; ++v) a[v] += sc[v * 1024 + k] * wv;
      }
      float* red = (float*)(smem + 40960);
#pragma unroll
      for (int v = 0; v < 9; ++v) red[(part * 9 + v) * 64 + (t & 63)] = a[v];
      __syncthreads();
      if (part == 0) {
        float* MOD = (float*)(P.ws + OFF_MOD);
#pragma unroll
        for (int v = 0; v < 9; ++v) {
          const float s = red[(0 * 9 + v) * 64 + t] + red[(1 * 9 + v) * 64 + t] + red[(2 * 9 + v) * 64 + t] +
                          red[(3 * 9 + v) * 64 + t] + P.b_mod[col];
          MOD[v * 3072 + col] = s;
        }
      }
      __syncthreads();
      tab_built = false;
    }
  }
}

DI void phase_ln_mod(const Params& P) {
  const int t = tid(), lane = t & 63, w = t >> 6;
  const float* POS = (const float*)(P.ws + OFF_POS);
  const float* MOD = (const float*)(P.ws + OFF_MOD);
  u16* H = (u16*)(P.ws + OFF_H);
  for (int row = blockIdx.x * 4 + w; row < NROWS; row += gridDim.x * 4) {
    const bool lat = row < NLAT;
    const float* src = lat ? (P.x + (size_t)row * 1024) : (P.ctx + (size_t)(row - NLAT) * 1024);
    const int n = row & 4095, pr = n >> 6, pc = n & 63;
    float v[16];
#pragma unroll
    for (int i = 0; i < 4; ++i) {
      const int col = lane * 4 + 256 * i;
      float4 a = *(const float4*)(src + col);
      if (lat) {
        const float* pp = (col < 512) ? (POS + pr * 512 + col) : (POS + 32768 + pc * 512 + (col - 512));
        float4 q = *(const float4*)pp;
        a.x += q.x; a.y += q.y; a.z += q.z; a.w += q.w;
      }
      v[4 * i] = a.x; v[4 * i + 1] = a.y; v[4 * i + 2] = a.z; v[4 * i + 3] = a.w;
    }
    float s = 0.f;
#pragma unroll
    for (int i = 0; i < 16; ++i) s += v[i];
    const float mean = wave_sum(s) * (1.f / 1024.f);
    float q = 0.f;
#pragma unroll
    for (int i = 0; i < 16; ++i) { const float d = v[i] - mean; q += d * d; }
    const float rstd = rsqrtf(wave_sum(q) * (1.f / 1024.f) + 1e-6f);
    const float* mr = MOD + (lat ? (row >> 12) : 8) * 3072;
#pragma unroll
    for (int i = 0; i < 4; ++i) {
      const int col = lane * 4 + 256 * i;
      const float4 sh = *(const float4*)(mr + col);
      const float4 scl = *(const float4*)(mr + 1024 + col);
      const float h0 = (v[4 * i] - mean) * rstd * (1.f + scl.x) + sh.x;
      const float h1 = (v[4 * i + 1] - mean) * rstd * (1.f + scl.y) + sh.y;
      const float h2 = (v[4 * i + 2] - mean) * rstd * (1.f + scl.z) + sh.z;
      const float h3 = (v[4 * i + 3] - mean) * rstd * (1.f + scl.w) + sh.w;
      u32x2 o = {pk2(h0, h1), pk2(h2, h3)};
      *(u32x2*)(H + (size_t)row * 1024 + col) = o;
    }
  }
}

DI void phase_gemm1(const Params& P, char* smem) {
  const u16* H = (const u16*)(P.ws + OFF_H);
  const u16* WT1 = (const u16*)(P.ws + OFF_WT1);
  u16* QKV = (u16*)(P.ws + OFF_QKV);
  float* BD = (float*)(P.ws + OFF_BD);
  u16* YT = (u16*)P.out;
  constexpr int NT_LAT = 256 * 33, NT_ALL = NT_LAT + 16 * 25;
  for (int id = blockIdx.x; id < NT_ALL; id += gridDim.x) {
    int mt, nt;
    if (id < NT_LAT) { mt = id / 33; nt = id - mt * 33; }
    else { const int id2 = id - NT_LAT; mt = 256 + id2 / 25; nt = 8 + (id2 - (id2 / 25) * 25); }
    f32x16 acc[2][2];
    zero_acc(acc);
    const u16* Hp = H + (size_t)mt * 128 * 1024;
    const u16* Wp = WT1 + (size_t)nt * 128 * 1024;
    if (nt < 8) {
      gemm_mainloop(Wp, 1024, Hp, 1024, 1024, acc, smem);
      const int b = mt >> 5, n0 = (mt & 31) * 128;
      u16* dst = YT + ((size_t)(b * 512 + (nt & 3) * 128)) * 8192 + (nt >> 2) * 4096 + n0;
      store_tile_bf16(acc, smem, dst, 8192, [](float v, int, int) { return v; });
    } else if (nt < 32) {
      gemm_mainloop(Hp, 1024, Wp, 1024, 1024, acc, smem);
      u16* dst = QKV + (size_t)mt * 128 * 3072 + (nt - 8) * 128;
      store_tile_bf16(acc, smem, dst, 3072, [](float v, int, int) { return v; });
    } else {
      gemm_mainloop(Hp, 1024, Wp, 1024, 1024, acc, smem);
      const int t = tid(), lane = t & 63, w = t >> 6, wm = w >> 1, wn = w & 1, fr = lane & 31, fh = lane >> 5;
      if (wn == 0) {
#pragma unroll
        for (int i = 0; i < 2; ++i)
#pragma unroll
          for (int g = 0; g < 16; ++g) {
            const int row = mt * 128 + wm * 64 + i * 32 + crow(g, fh);
            BD[(size_t)row * 32 + fr] = acc[i][0][g];
          }
      }
      __syncthreads();
    }
  }
}

DI void prep_unit(const Params& P, int b, int h, int dir, int cs, int isctx, int slot, int cj, char* smem) {
  const int t = tid(), lane = t & 63, w = t >> 6;
  const int fr = lane & 31, fh = lane >> 5;
  const int nchunks = isctx ? 4 : 64;
  const int corig = dir ? (nchunks - 1 - cs) : cs;
  const int seqlen = isctx ? 256 : 4096;
  const size_t rowbase = isctx ? (size_t)(NLAT + b * 256) : (size_t)(b * 4096);
  const int r0 = corig * 64;
  const int scan_id = (b * 8 + h) * 2 + dir;
  const u16* QKV = (const u16*)(P.ws + OFF_QKV);
  const float* BD = (const float*)(P.ws + OFF_BD);
  char* blob = P.ws + OFF_OPBUF + (size_t)slot * OPBUF_SLOT + (size_t)(scan_id * 8 + cj) * BLOB;
  u16* q_s = (u16*)(smem);
  u16* k_s = (u16*)(smem + 17408);
  u16* kT_s = (u16*)(smem + 34816);
  u16* vT_s = (u16*)(smem + 53248);
  float* sc = (float*)(smem + 71680);
  float* A_s = (float*)smem;
  u16* Tu_s = (u16*)(smem + 16384);
  u16* Tw_s = (u16*)(smem + 25600);

  {
    const int cg8 = (t & 15) * 8, rg = t >> 4;
#pragma unroll 1
    for (int part = 0; part < 3; ++part) {
      const int colbase = part * 1024 + h * 128 + cg8;
      float w0[8], w1[8], w2[8];
#pragma unroll
      for (int e = 0; e < 8; ++e) {
        w0[e] = P.conv_w[colbase + e];
        w1[e] = P.conv_w[3072 + colbase + e];
        w2[e] = P.conv_w[6144 + colbase + e];
      }
      float xin[6][8];
#pragma unroll
      for (int rr = 0; rr < 6; ++rr) {
        const int r = r0 + rg * 4 - 1 + rr;
        u32x4 v = {0u, 0u, 0u, 0u};
        if (r >= 0 && r < seqlen) v = *(const u32x4*)(QKV + (rowbase + r) * 3072 + colbase);
#pragma unroll
        for (int e = 0; e < 4; ++e) { xin[rr][2 * e] = bflo(v[e]); xin[rr][2 * e + 1] = bfhi(v[e]); }
      }
#pragma unroll
      for (int a = 0; a < 4; ++a) {
        float y[8];
        float ss = 0.f;
#pragma unroll
        for (int e = 0; e < 8; ++e) {
          const float z = xin[a][e] * w0[e] + xin[a + 1][e] * w1[e] + xin[a + 2][e] * w2[e];
          y[e] = silu_f(z);
          ss += y[e] * y[e];
        }
        if (part < 2) {
          ss += __shfl_xor(ss, 1); ss += __shfl_xor(ss, 2); ss += __shfl_xor(ss, 4); ss += __shfl_xor(ss, 8);
          const float inv = rsqrtf(ss + 1e-6f);
#pragma unroll
          for (int e = 0; e < 8; ++e) y[e] *= inv;
        }
        const int rloc = rg * 4 + a;
        const int i = dir ? (63 - rloc) : rloc;
        u32x4 pv = {pk2(y[0], y[1]), pk2(y[2], y[3]), pk2(y[4], y[5]), pk2(y[6], y[7])};
        if (part == 0) {
          *(u32x4*)(q_s + i * 136 + cg8) = pv;
        } else if (part == 1) {
          *(u32x4*)(k_s + i * 136 + cg8) = pv;
#pragma unroll
          for (int e = 0; e < 8; ++e) kT_s[(cg8 + e) * 72 + i] = (u16)((pv[e >> 1] >> ((e & 1) * 16)) & 0xffffu);
        } else {
#pragma unroll
          for (int e = 0; e < 8; ++e) vT_s[(cg8 + e) * 72 + i] = (u16)((pv[e >> 1] >> ((e & 1) * 16)) & 0xffffu);
        }
      }
    }
  }
  if (w == 0) {
    const int i = lane;
    const int rloc = dir ? (63 - i) : i;
    const size_t grow = rowbase + r0 + rloc;
    const float braw = BD[grow * 32 + dir * 8 + h];
    const float draw = BD[grow * 32 + 16 + dir * 8 + h];
    const float beta = sigm_f(braw);
    const float xx = draw + P.dt_bias[dir * 8 + h];
    const float sp = (xx > 20.f) ? xx : log1pf(expf(xx));
    float s = -expf(P.a_log[dir * 8 + h]) * sp;
#pragma unroll
    for (int d = 1; d < 64; d <<= 1) {
      const float o = __shfl_up(s, d);
      if (lane >= d) s += o;
    }
    sc[i] = beta;
    sc[64 + i] = s;
  }
  __syncthreads();

  const float gcl = sc[64 + 63];
  f32x16 kk = zero16();
  {
    const int ti = w >> 1, tj = w & 1;
    if (w != 1) {
#pragma unroll
      for (int s8 = 0; s8 < 8; ++s8) {
        bf16x8 a = *(const bf16x8*)(k_s + (ti * 32 + fr) * 136 + s8 * 16 + fh * 8);
        bf16x8 bb = *(const bf16x8*)(k_s + (tj * 32 + fr) * 136 + s8 * 16 + fh * 8);
        kk = MFMA(a, bb, kk);
      }
    }
    if (w != 2) {
      const int tj2 = w >> 1, ti2 = w & 1;
      f32x16 qkt = zero16();
#pragma unroll
      for (int s8 = 0; s8 < 8; ++s8) {
        bf16x8 a = *(const bf16x8*)(k_s + (tj2 * 32 + fr) * 136 + s8 * 16 + fh * 8);
        bf16x8 bb = *(const bf16x8*)(q_s + (ti2 * 32 + fr) * 136 + s8 * 16 + fh * 8);
        qkt = MFMA(a, bb, qkt);
      }
      const int i = ti2 * 32 + fr;
      const float gci = sc[64 + i];
      f32x16 val;
#pragma unroll
      for (int g = 0; g < 16; ++g) {
        const int j = tj2 * 32 + crow(g, fh);
        val[g] = (i >= j) ? qkt[g] * 0.08838834764831845f * __expf(gci - sc[64 + j]) : 0.f;
      }
#pragma unroll
      for (int s = 0; s < 2; ++s) {
        bf16x8 pv = pack_step(val, s);
        *(bf16x8*)(blob + 49152 + (size_t)((((ti2 * 2 + tj2) * 2 + s) * 64 + lane) * 16)) = pv;
      }
    }
  }
#pragma unroll
  for (int p = 0; p < 4; ++p) {
    const int idx = t + 256 * p;
    const int ln = idx & 63, s = (idx >> 6) & 1, tk = (idx >> 7) & 3, ti = idx >> 9;
    const int i = ti * 32 + (ln & 31), hh = ln >> 5;
    const int dk0 = tk * 32 + 16 * s + 4 * hh;
    const u32x2 lo = *(const u32x2*)(q_s + i * 136 + dk0);
    const u32x2 hi = *(const u32x2*)(q_s + i * 136 + dk0 + 8);
    const float sci = 0.08838834764831845f * __expf(sc[64 + i]);
    u32x4 o = {pk2(bflo(lo[0]) * sci, bfhi(lo[0]) * sci), pk2(bflo(lo[1]) * sci, bfhi(lo[1]) * sci),
               pk2(bflo(hi[0]) * sci, bfhi(hi[0]) * sci), pk2(bflo(hi[1]) * sci, bfhi(hi[1]) * sci)};
    *(u32x4*)(blob + 16384 + (size_t)idx * 16) = o;
  }
#pragma unroll
  for (int p = 0; p < 4; ++p) {
    const int idx = t + 256 * p;
    const int ln = idx & 63, s = (idx >> 6) & 1, ti = (idx >> 7) & 1, tm = idx >> 8;
    const int dk = tm * 32 + (ln & 31), hh = ln >> 5;
    const int i0 = ti * 32 + 16 * s + 4 * hh;
    const u32x2 lo = *(const u32x2*)(kT_s + dk * 72 + i0);
    const u32x2 hi = *(const u32x2*)(kT_s + dk * 72 + i0 + 8);
    const float e0 = __expf(gcl - sc[64 + i0]), e1 = __expf(gcl - sc[64 + i0 + 1]), e2 = __expf(gcl - sc[64 + i0 + 2]),
                e3 = __expf(gcl - sc[64 + i0 + 3]);
    const float e4 = __expf(gcl - sc[64 + i0 + 8]), e5 = __expf(gcl - sc[64 + i0 + 9]), e6 = __expf(gcl - sc[64 + i0 + 10]),
                e7 = __expf(gcl - sc[64 + i0 + 11]);
    u32x4 o = {pk2(bflo(lo[0]) * e0, bfhi(lo[0]) * e1), pk2(bflo(lo[1]) * e2, bfhi(lo[1]) * e3),
               pk2(bflo(hi[0]) * e4, bfhi(hi[0]) * e5), pk2(bflo(hi[1]) * e6, bfhi(hi[1]) * e7)};
    *(u32x4*)(blob + 32768 + (size_t)idx * 16) = o;
  }
  __syncthreads();

  if (w != 1) {
    const int ti = w >> 1, tj = w & 1;
    const int j = tj * 32 + fr;
    const float gcj = sc[64 + j];
#pragma unroll
    for (int g = 0; g < 16; ++g) {
      const int i = ti * 32 + crow(g, fh);
      A_s[i * 64 + j] = (i > j) ? sc[i] * kk[g] * __expf(sc[64 + i] - gcj) : 0.f;
    }
  }
  __syncthreads();

  if (w == 0) {
    float tt[64];
#pragma unroll
    for (int i = 0; i < 64; ++i) {
      float s0 = 0.f, s1 = 0.f, s2 = 0.f, s3 = 0.f;
#pragma unroll
      for (int j4 = 0; j4 < (i + 3) / 4; ++j4) {
        const float4 l = *(const float4*)(A_s + i * 64 + j4 * 4);
        if (j4 * 4 + 0 < i) s0 += l.x * tt[j4 * 4 + 0];
        if (j4 * 4 + 1 < i) s1 += l.y * tt[j4 * 4 + 1];
        if (j4 * 4 + 2 < i) s2 += l.z * tt[j4 * 4 + 2];
        if (j4 * 4 + 3 < i) s3 += l.w * tt[j4 * 4 + 3];
      }
      tt[i] = ((lane == i) ? 1.f : 0.f) - ((s0 + s1) + (s2 + s3));
    }
    const float bc = sc[lane];
    const float bge = -bc * __expf(sc[64 + lane]);
#pragma unroll
    for (int i = 0; i < 64; ++i) {
      Tu_s[i * 72 + lane] = f2bf(tt[i] * bc);
      Tw_s[i * 72 + lane] = f2bf(tt[i] * bge);
    }
  }
  __syncthreads();

#pragma unroll
  for (int ti = 0; ti < 2; ++ti) {
    f32x16 au = zero16(), aw = zero16();
#pragma unroll
    for (int s4 = 0; s4 < 4; ++s4) {
      bf16x8 a = *(const bf16x8*)(Tu_s + (ti * 32 + fr) * 72 + s4 * 16 + fh * 8);
      bf16x8 bb = *(const bf16x8*)(vT_s + (w * 32 + fr) * 72 + s4 * 16 + fh * 8);
      au = MFMA(a, bb, au);
      bf16x8 a2 = *(const bf16x8*)(kT_s + (w * 32 + fr) * 72 + s4 * 16 + fh * 8);
      bf16x8 b2 = *(const bf16x8*)(Tw_s + (ti * 32 + fr) * 72 + s4 * 16 + fh * 8);
      aw = MFMA(a2, b2, aw);
    }
    bf16x8 u0 = pack_step(au, 0), u1 = pack_step(au, 1);
    char* up = blob + 57344 + (size_t)(((ti * 4 + w) * 64 + lane) * 32);
    *(bf16x8*)(up) = u0;
    *(bf16x8*)(up + 16) = u1;
#pragma unroll
    for (int s = 0; s < 2; ++s) {
      bf16x8 pv = pack_step(aw, s);
      *(bf16x8*)(blob + (size_t)((((ti * 4 + w) * 2 + s) * 64 + lane) * 16)) = pv;
    }
  }
  if (t == 0) ((float*)(P.ws + OFF_GL))[(slot * 128 + scan_id) * 8 + cj] = __expf(gcl);
  __syncthreads();
}

DI void prep_segment(const Params& P, int seg, int first, int stride, char* smem) {
  const int nch = seg == 0 ? 4 : 8;
  const int total = 128 * nch;
  for (int u = first; u < total; u += stride) {
    const int cj = u % nch, sid = u / nch;
    const int b = sid >> 4, h = (sid >> 1) & 7, dir = sid & 1;
    const int cs = seg == 0 ? cj : (seg - 1) * 8 + cj;
    prep_unit(P, b, h, dir, cs, seg == 0, seg & 1, cj, smem);
  }
}

DI void phase_dft(const Params& P, char* smem) {
  const u16* YT = (const u16*)P.out;
  const u16* TRIG = (const u16*)P.out + (size_t)4096 * 8192;
  u16* MIXED = (u16*)(P.ws + OFF_MIXED);
  const int total = 1024 + 512;
  for (int id = blockIdx.x; id < total; id += gridDim.x) {
    if (id < 1024) {
      const int kt = id >> 5, b = (id >> 2) & 7, nt = id & 3;
      f32x16 acc[2][2];
      zero_acc(acc);
      gemm_mainloop(TRIG + (size_t)kt * 128 * 8192, 8192, YT + (size_t)(b * 512 + nt * 128) * 8192, 8192, 8192, acc, smem);
      u16* dst = MIXED + ((size_t)(b * 4096 + kt * 128)) * 512 + nt * 128;
      store_tile_bf16(acc, smem, dst, 512, [](float v, int, int) { return v * 0.0013810679320049757f; });
    } else {
      const int u = id - 1024;
      const int cj = u & 3, sid = u >> 2;
      prep_unit(P, sid >> 4, (sid >> 1) & 7, sid & 1, cj, 1, 0, cj, smem);
    }
  }
}

DI void scan_segment(const Params& P, int seg, char* smem) {
  const int t = tid(), lane = t & 63, w = t >> 6;
  const int fr = lane & 31, fh = lane >> 5;
  const int sb = blockIdx.x;
  const int b = sb >> 4, h = (sb >> 1) & 7, dir = sb & 1;
  const int nch = seg == 0 ? 4 : 8, slot = seg & 1;
  float* ST = (float*)(P.ws + OFF_STATE) + (size_t)((sb * 4 + w) * 4) * 1024;
  const float* GL = (const float*)(P.ws + OFF_GL) + (slot * 128 + sb) * 8;
  u16* OB = (u16*)P.out + (size_t)dir * NLAT * 1024;
  f32x16 S[4];
#pragma unroll
  for (int tm = 0; tm < 4; ++tm) {
    if (seg == 0) S[tm] = zero16();
    else {
#pragma unroll
      for (int q = 0; q < 4; ++q) {
        const float4 v = *(const float4*)(ST + tm * 1024 + lane * 16 + q * 4);
        S[tm][4 * q] = v.x; S[tm][4 * q + 1] = v.y; S[tm][4 * q + 2] = v.z; S[tm][4 * q + 3] = v.w;
      }
    }
  }
#pragma unroll 1
  for (int cj = 0; cj < nch; ++cj) {
    const char* blob = P.ws + OFF_OPBUF + (size_t)slot * OPBUF_SLOT + (size_t)(sb * 8 + cj) * BLOB;
#pragma unroll
    for (int p = 0; p < 14; ++p) {
      const u32x4 v = *(const u32x4*)(blob + (size_t)(t + 256 * p) * 16);
      *(u32x4*)(smem + (t + 256 * p) * 16) = v;
    }
    f32x16 vn[2];
#pragma unroll
    for (int ti = 0; ti < 2; ++ti) {
      const char* up = blob + 57344 + (size_t)(((ti * 4 + w) * 64 + lane) * 32);
      const u32x4 a = *(const u32x4*)up, c2 = *(const u32x4*)(up + 16);
#pragma unroll
      for (int e = 0; e < 4; ++e) {
        vn[ti][2 * e] = bflo(a[e]); vn[ti][2 * e + 1] = bfhi(a[e]);
        vn[ti][8 + 2 * e] = bflo(c2[e]); vn[ti][8 + 2 * e + 1] = bfhi(c2[e]);
      }
    }
    const float glv = GL[cj];
    __syncthreads();
    bf16x8 Sb[4][2];
#pragma unroll
    for (int tm = 0; tm < 4; ++tm) { Sb[tm][0] = pack_step(S[tm], 0); Sb[tm][1] = pack_step(S[tm], 1); }
    f32x16 o[2];
#pragma unroll
    for (int ti = 0; ti < 2; ++ti) {
      o[ti] = zero16();
#pragma unroll
      for (int tk = 0; tk < 4; ++tk)
#pragma unroll
        for (int s = 0; s < 2; ++s) {
          const int fo = (((ti * 4 + tk) * 2 + s) * 64 + lane) * 16;
          const bf16x8 wf = *(const bf16x8*)(smem + fo);
          vn[ti] = MFMA(wf, Sb[tk][s], vn[ti]);
          if (seg > 0) {
            const bf16x8 qf = *(const bf16x8*)(smem + 16384 + fo);
            o[ti] = MFMA(qf, Sb[tk][s], o[ti]);
          }
        }
    }
    bf16x8 vb[2][2];
#pragma unroll
    for (int ti = 0; ti < 2; ++ti) { vb[ti][0] = pack_step(vn[ti], 0); vb[ti][1] = pack_step(vn[ti], 1); }
    if (seg > 0) {
#pragma unroll
      for (int ti = 0; ti < 2; ++ti)
#pragma unroll
        for (int tj = 0; tj <= ti; ++tj)
#pragma unroll
          for (int s = 0; s < 2; ++s) {
            const bf16x8 qf = *(const bf16x8*)(smem + 49152 + (((ti * 2 + tj) * 2 + s) * 64 + lane) * 16);
            o[ti] = MFMA(qf, vb[tj][s], o[ti]);
          }
      const int cs = (seg - 1) * 8 + cj;
      const int corig = dir ? (63 - cs) : cs;
      int sgn = dir ? -1024 : 1024;
      asm volatile("" : "+v"(sgn));
      const int base_idx = (b * 4096 + corig * 64 + (dir ? (63 - 4 * fh) : (4 * fh))) * 1024 + h * 128 + w * 32 + fr;
#pragma unroll
      for (int ti = 0; ti < 2; ++ti)
#pragma unroll
        for (int g = 0; g < 16; ++g) {
          const int idx = base_idx + sgn * (ti * 32 + (g & 3) + 8 * (g >> 2));
          OB[idx] = f2bf(o[ti][g]);
        }
    }
#pragma unroll
    for (int tm = 0; tm < 4; ++tm) {
#pragma unroll
      for (int g = 0; g < 16; ++g) S[tm][g] *= glv;
#pragma unroll
      for (int ti = 0; ti < 2; ++ti)
#pragma unroll
        for (int s = 0; s < 2; ++s) {
          const bf16x8 kf = *(const bf16x8*)(smem + 32768 + (((tm * 2 + ti) * 2 + s) * 64 + lane) * 16);
          S[tm] = MFMA(kf, vb[ti][s], S[tm]);
        }
    }
    __syncthreads();
  }
#pragma unroll
  for (int tm = 0; tm < 4; ++tm)
#pragma unroll
    for (int q = 0; q < 4; ++q) {
      float4 v = {S[tm][4 * q], S[tm][4 * q + 1], S[tm][4 * q + 2], S[tm][4 * q + 3]};
      *(float4*)(ST + tm * 1024 + lane * 16 + q * 4) = v;
    }
}

DI void phase_gates(const Params& P, char* smem) {
  const u16* H = (const u16*)(P.ws + OFF_H);
  const u16* WT1 = (const u16*)(P.ws + OFF_WT1);
  u16* GATES = (u16*)(P.ws + OFF_GATES);
  for (int id = blockIdx.x; id < 256 * 28; id += gridDim.x) {
    const int mt = id / 28, nt = id - mt * 28;
    f32x16 acc[2][2];
    zero_acc(acc);
    gemm_mainloop(H + (size_t)mt * 128 * 1024, 1024, WT1 + (size_t)(4224 + nt * 128) * 1024, 1024, 1024, acc, smem);
    u16* dst = GATES + (size_t)mt * 128 * 3584 + nt * 128;
    if (nt < 12) store_tile_bf16(acc, smem, dst, 3584, [](float v, int, int) { return silu_f(v); });
    else store_tile_bf16(acc, smem, dst, 3584, [](float v, int, int) { return sigm_f(v); });
  }
}

DI void phase_od_fmix(const Params& P, char* smem) {
  const int t = tid();
  const u16* GATES = (const u16*)(P.ws + OFF_GATES);
  {
    const u16* OF = (const u16*)P.out;
    const u16* OBk = (const u16*)P.out + (size_t)NLAT * 1024;
    u16* OD = (u16*)(P.ws + OFF_OD);
    const int d0 = (t & 15) * 8;
    float nw[8];
#pragma unroll
    for (int e = 0; e < 8; ++e) nw[e] = P.dn_norm_w[d0 + e];
    for (int it = blockIdx.x; it < NLAT * 8 / 16; it += gridDim.x) {
      const int pair = it * 16 + (t >> 4);
      const size_t token = pair >> 3;
      const int hh = pair & 7;
      const size_t off = token * 1024 + hh * 128 + d0;
      const u32x4 a = *(const u32x4*)(OF + off), bq = *(const u32x4*)(OBk + off);
      const u32x4 gt = *(const u32x4*)(GATES + token * 3584 + 512 + hh * 128 + d0);
      float o[8];
      float ss = 0.f;
#pragma unroll
      for (int e = 0; e < 4; ++e) {
        o[2 * e] = bflo(a[e]) + bflo(bq[e]);
        o[2 * e + 1] = bfhi(a[e]) + bfhi(bq[e]);
        ss += o[2 * e] * o[2 * e] + o[2 * e + 1] * o[2 * e + 1];
      }
      ss += __shfl_xor(ss, 1); ss += __shfl_xor(ss, 2); ss += __shfl_xor(ss, 4); ss += __shfl_xor(ss, 8);
      const float r = rsqrtf(ss * (1.f / 128.f) + 1e-6f);
      u32x4 ov;
#pragma unroll
      for (int e = 0; e < 4; ++e)
        ov[e] = pk2(o[2 * e] * r * nw[2 * e] * bflo(gt[e]), o[2 * e + 1] * r * nw[2 * e + 1] * bfhi(gt[e]));
      *(u32x4*)(OD + off) = ov;
    }
  }
  {
    const u16* MIXED = (const u16*)(P.ws + OFF_MIXED);
    const u16* WFMIX = (const u16*)(P.ws + OFF_WFMIX);
    u16* MG = (u16*)(P.ws + OFF_MG);
    for (int id = blockIdx.x; id < 1024; id += gridDim.x) {
      const int mt = id >> 2, g = id & 3;
      f32x16 acc[2][2];
      zero_acc(acc);
      gemm_mainloop(MIXED + (size_t)mt * 128 * 512 + g * 128, 512, WFMIX + (size_t)g * 128 * 128, 128, 128, acc, smem);
      const u16* gp = GATES + (size_t)mt * 128 * 3584 + g * 128;
      u16* dst = MG + (size_t)mt * 128 * 512 + g * 128;
      stage_tile(acc, smem, [](float v, int, int) { return v; });
#pragma unroll
      for (int p = 0; p < 8; ++p) {
        int row, c8;
        const u32x4 v = staged_piece(smem, p, row, c8);
        const u32x4 gt = *(const u32x4*)(gp + (size_t)row * 3584 + c8);
        *(u32x4*)(dst + (size_t)row * 512 + c8) = mul_bf8(v, gt);
      }
      __syncthreads();
    }
  }
}

DI void phase_merge(const Params& P, char* smem) {
  const u16* GATES = (const u16*)(P.ws + OFF_GATES);
  const u16* MG = (const u16*)(P.ws + OFF_MG);
  const u16* OD = (const u16*)(P.ws + OFF_OD);
  const u16* WFOUT = (const u16*)(P.ws + OFF_WFOUT);
  const u16* WDN = (const u16*)(P.ws + OFF_WDN);
  u16* MERGED = (u16*)(P.ws + OFF_MERGED);
  const int t = tid(), lane = t & 63, w = t >> 6, wm = w >> 1, wn = w & 1, fr = lane & 31, fh = lane >> 5;
  for (int id = blockIdx.x; id < 2048; id += gridDim.x) {
    const int mt = id >> 3, nt = id & 7;
    f32x16 a1[2][2], a2[2][2];
    zero_acc(a1);
    gemm_mainloop(MG + (size_t)mt * 128 * 512, 512, WFOUT + (size_t)nt * 128 * 512, 512, 512, a1, smem);
    const u16* gp = GATES + (size_t)mt * 128 * 3584 + 1536 + nt * 128;
    zero_acc(a2);
    gemm_mainloop(OD + (size_t)mt * 128 * 1024, 1024, WDN + (size_t)nt * 128 * 1024, 1024, 1024, a2, smem);
    u16* dst = MERGED + (size_t)mt * 128 * 1024 + nt * 128;
    stage_tile(a1, smem, [](float v, int, int) { return v; });
    u32x4 p1[8];
#pragma unroll
    for (int p = 0; p < 8; ++p) { int row, c8; p1[p] = staged_piece(smem, p, row, c8); }
    __syncthreads();
    stage_tile(a2, smem, [](float v, int, int) { return v; });
#pragma unroll
    for (int p = 0; p < 8; ++p) {
      int row, c8;
      const u32x4 v2 = staged_piece(smem, p, row, c8);
      const u32x4 rf = *(const u32x4*)(gp + (size_t)row * 3584 + c8);
      const u32x4 rd = *(const u32x4*)(gp + (size_t)row * 3584 + 1024 + c8);
      u32x4 o;
#pragma unroll
      for (int e = 0; e < 4; ++e)
        o[e] = pk2(bflo(p1[p][e]) * bflo(rf[e]) + bflo(v2[e]) * bflo(rd[e]), bfhi(p1[p][e]) * bfhi(rf[e]) + bfhi(v2[e]) * bfhi(rd[e]));
      *(u32x4*)(dst + (size_t)row * 1024 + c8) = o;
    }
    __syncthreads();
  }
}

DI void phase_out(const Params& P, char* smem) {
  const u16* MERGED = (const u16*)(P.ws + OFF_MERGED);
  const u16* WOUT = (const u16*)(P.ws + OFF_WOUT);
  const float* POS = (const float*)(P.ws + OFF_POS);
  const float* MOD = (const float*)(P.ws + OFF_MOD);
  const int t = tid(), lane = t & 63, w = t >> 6, wm = w >> 1, wn = w & 1, fr = lane & 31, fh = lane >> 5;
  for (int id = blockIdx.x; id < 2048; id += gridDim.x) {
    const int mt = id >> 3, nt = id & 7;
    f32x16 acc[2][2];
    zero_acc(acc);
    gemm_mainloop(MERGED + (size_t)mt * 128 * 1024, 1024, WOUT + (size_t)nt * 128 * 1024, 1024, 1024, acc, smem);
    const int b = mt >> 5;
#pragma unroll
    for (int i = 0; i < 2; ++i)
#pragma unroll
      for (int j = 0; j < 2; ++j) {
        const int col = nt * 128 + wn * 64 + j * 32 + fr;
        const float gate = MOD[b * 3072 + 2048 + col];
#pragma unroll
        for (int g = 0; g < 16; ++g) {
          const int row = mt * 128 + wm * 64 + i * 32 + crow(g, fh);
          const int n = row & 4095, pr = n >> 6, pc = n & 63;
          const float pe = (col < 512) ? POS[pr * 512 + col] : POS[32768 + pc * 512 + (col - 512)];
          const float xv = P.x[(size_t)row * 1024 + col] + pe;
          P.out[(size_t)row * 1024 + col] = 1.189207115002721f * xv + gate * acc[i][j][g];
        }
      }
  }
}

DI void phase_final_ln(const Params& P) {
  const int t = tid(), lane = t & 63, w = t >> 6;
  for (int row = blockIdx.x * 4 + w; row < NLAT; row += gridDim.x * 4) {
    float* p = P.out + (size_t)row * 1024;
    float v[16];
#pragma unroll
    for (int i = 0; i < 4; ++i) {
      const float4 a = *(const float4*)(p + lane * 4 + 256 * i);
      v[4 * i] = a.x; v[4 * i + 1] = a.y; v[4 * i + 2] = a.z; v[4 * i + 3] = a.w;
    }
    float s = 0.f;
#pragma unroll
    for (int i = 0; i < 16; ++i) s += v[i];
    const float mean = wave_sum(s) * (1.f / 1024.f);
    float q = 0.f;
#pragma unroll
    for (int i = 0; i < 16; ++i) { const float d = v[i] - mean; q += d * d; }
    const float rstd = rsqrtf(wave_sum(q) * (1.f / 1024.f) + 1e-6f);
#pragma unroll
    for (int i = 0; i < 4; ++i) {
      const int col = lane * 4 + 256 * i;
      const float4 g = *(const float4*)(P.ln_g + col);
      const float4 bb = *(const float4*)(P.ln_b + col);
      float4 o;
      o.x = (v[4 * i] - mean) * rstd * g.x + bb.x;
      o.y = (v[4 * i + 1] - mean) * rstd * g.y + bb.y;
      o.z = (v[4 * i + 2] - mean) * rstd * g.z + bb.z;
      o.w = (v[4 * i + 3] - mean) * rstd * g.w + bb.w;
      *(float4*)(p + col) = o;
    }
  }
}

__global__ void __launch_bounds__(256, 2) fwd_megakernel(Params P0) {
  __shared__ __attribute__((aligned(16))) char smem[SMEM_BYTES];
  cg::grid_group grid = cg::this_grid();
  for (int ph = P0.phase_lo; ph <= P0.phase_hi; ++ph) {
    const Params& P = P0;
    switch (ph) {
      case 0: phase_prep(P, smem); break;
      case 1: phase_ln_mod(P); break;
      case 2: phase_gemm1(P, smem); break;
      case 3: phase_dft(P, smem); break;
      case 13: phase_gates(P, smem); break;
      case 14: phase_od_fmix(P, smem); break;
      case 15: phase_merge(P, smem); break;
      case 16: phase_out(P, smem); break;
      case 17: phase_final_ln(P); break;
      default: {
        const int seg = ph - 4;
        if (blockIdx.x < 128) scan_segment(P, seg, smem);
        else if (seg < 8) prep_segment(P, seg + 1, blockIdx.x - 128, gridDim.x - 128, smem);
      } break;
    }
    if (ph < P0.phase_hi) grid.sync();
  }
}

extern "C" void kernel_launch(void* const* d_in, const int* in_sizes, int n_in, void* d_out, int out_size, void* d_ws,
                              size_t ws_size, hipStream_t stream) {
  (void)in_sizes; (void)n_in; (void)out_size;
  if (ws_size < WS_NEEDED) { fprintf(stderr, "workspace too small: %zu < %zu\n", ws_size, (size_t)WS_NEEDED); return; }
  static int grid_blocks = 0;
  if (!grid_blocks) {
    int dev = 0, cus = 0, per_cu = 0;
    hipGetDevice(&dev);
    hipDeviceGetAttribute(&cus, hipDeviceAttributeMultiprocessorCount, dev);
    hipOccupancyMaxActiveBlocksPerMultiprocessor(&per_cu, fwd_megakernel, 256, 0);
    if (per_cu > 2) per_cu = 2;
    if (per_cu < 1) per_cu = 1;
    grid_blocks = cus * per_cu;
  }
  Params p{};
  p.x = (const float*)d_in[0]; p.c = (const float*)d_in[1]; p.ctx = (const float*)d_in[2]; p.c_ctx = (const float*)d_in[3];
  p.w_mod = (const float*)d_in[4]; p.b_mod = (const float*)d_in[5]; p.w_in = (const float*)d_in[6];
  p.conv_w = (const float*)d_in[7]; p.a_log = (const float*)d_in[8]; p.dt_bias = (const float*)d_in[9];
  p.dn_norm_w = (const float*)d_in[10]; p.w_dn_out = (const float*)d_in[11]; p.w_fmix = (const float*)d_in[12];
  p.w_f_out = (const float*)d_in[13]; p.w_out = (const float*)d_in[14]; p.ln_g = (const float*)d_in[15];
  p.ln_b = (const float*)d_in[16];
  p.out = (float*)d_out;
  p.ws = (char*)d_ws;
#if MK_MULTI
  for (int ph = 0; ph < NPHASE; ++ph) {
    p.phase_lo = ph; p.phase_hi = ph;
    hipLaunchKernelGGL(fwd_megakernel, dim3(grid_blocks), dim3(256), 0, stream, p);
  }
#else
  p.phase_lo = 0; p.phase_hi = NPHASE - 1;
  void* args[] = {&p};
  hipError_t e = hipLaunchCooperativeKernel((void*)fwd_megakernel, dim3(grid_blocks), dim3(256), args, 0, stream);
  if (e != hipSuccess) fprintf(stderr, "cooperative launch failed: %s (grid %d)\n", hipGetErrorString(e), grid_blocks);
#endif
}
```

```cpp
#include <hip/hip_runtime.h>
#include <hip/hip_cooperative_groups.h>
#include <cstdio>
namespace cg = cooperative_groups;

#ifndef MK_MULTI
#define MK_MULTI 0
#endif
#ifndef PROBE_DUP
#define PROBE_DUP -1
#endif
#ifndef PROBE_DUP_PREP
#define PROBE_DUP_PREP 0
#endif

typedef unsigned short u16;
using bf16x8 = __attribute__((ext_vector_type(8))) short;
using f32x16 = __attribute__((ext_vector_type(16))) float;
using f32x4 = __attribute__((ext_vector_type(4))) float;
using u32x4 = __attribute__((ext_vector_type(4))) unsigned;
using u32x2 = __attribute__((ext_vector_type(2))) unsigned;
typedef __bf16 bf2_t __attribute__((ext_vector_type(2)));
typedef float f2_t __attribute__((ext_vector_type(2)));
#define DI __device__ __forceinline__
#define MFMA(a, b, c) __builtin_amdgcn_mfma_f32_32x32x16_bf16((a), (b), (c), 0, 0, 0)

constexpr int NLAT = 32768;
constexpr int NROWS = 34816;
constexpr size_t MiB = 1u << 20;
constexpr size_t OFF_WT1 = 0;
constexpr size_t OFF_WFMIX = 16 * MiB;
constexpr size_t OFF_WFOUT = 17 * MiB;
constexpr size_t OFF_WDN = 18 * MiB;
constexpr size_t OFF_WOUT = 20 * MiB;
constexpr size_t OFF_POS = 22 * MiB;
constexpr size_t OFF_MOD = 23 * MiB;
constexpr size_t OFF_GL = 23 * MiB + 512 * 1024;
constexpr size_t OFF_BAR = 23 * MiB + 768 * 1024;
constexpr size_t OFF_STATE = 24 * MiB;
constexpr size_t OFF_BD = 32 * MiB;
constexpr size_t OFF_H = 37 * MiB;
constexpr size_t OFF_MIXED = 105 * MiB;
constexpr size_t OFF_QKV = 137 * MiB;
constexpr size_t OFF_OPBUF = 341 * MiB;
constexpr size_t OPBUF_SLOT = 72 * MiB;
constexpr size_t OFF_GATES = 137 * MiB;
constexpr size_t OFF_OD = 361 * MiB;
constexpr size_t OFF_MG = 425 * MiB;
constexpr size_t OFF_MERGED = 37 * MiB;
constexpr size_t WS_NEEDED = 485 * MiB;
constexpr int BLOB = 73728;
constexpr int HALF_SMEM = 73728;
constexpr int SMEM_BYTES = 2 * HALF_SMEM;
constexpr int NPHASE = 19;
constexpr int WT1_GATES_ROW = 4352;

struct Params {
  const float *x, *c, *ctx, *c_ctx, *w_mod, *b_mod, *w_in, *conv_w, *a_log, *dt_bias, *dn_norm_w, *w_dn_out, *w_fmix,
      *w_f_out, *w_out, *ln_g, *ln_b;
  float* out;
  char* ws;
  int phase_lo, phase_hi;
};

DI unsigned pk2(float a, float b) {
  f2_t v = {a, b};
  bf2_t r = __builtin_convertvector(v, bf2_t);
  return __builtin_bit_cast(unsigned, r);
}
DI u16 f2bf(float a) { return (u16)(pk2(a, 0.f) & 0xffffu); }
DI float bf2f(u16 v) { return __uint_as_float(((unsigned)v) << 16); }
DI float bflo(unsigned v) { return __uint_as_float(v << 16); }
DI float bfhi(unsigned v) { return __uint_as_float(v & 0xffff0000u); }
DI float silu_f(float x) { return x * __builtin_amdgcn_rcpf(1.f + __expf(-x)); }
DI float sigm_f(float x) { return __builtin_amdgcn_rcpf(1.f + __expf(-x)); }
DI int ltid() { int t = threadIdx.x; asm volatile("" : "+v"(t)); return t; }
DI int crow(int reg, int h) { return (reg & 3) + 8 * (reg >> 2) + 4 * h; }
DI bf16x8 pack_step(const f32x16& x, int s) {
  u32x4 p;
  p[0] = pk2(x[8 * s + 0], x[8 * s + 1]);
  p[1] = pk2(x[8 * s + 2], x[8 * s + 3]);
  p[2] = pk2(x[8 * s + 4], x[8 * s + 5]);
  p[3] = pk2(x[8 * s + 6], x[8 * s + 7]);
  return __builtin_bit_cast(bf16x8, p);
}
DI f32x16 zero16() {
  f32x16 z;
#pragma unroll
  for (int i = 0; i < 16; ++i) z[i] = 0.f;
  return z;
}
#define DPP_ADD(v, CTRL) ((v) + __builtin_bit_cast(float, __builtin_amdgcn_update_dpp(0, __builtin_bit_cast(int, (v)), (CTRL), 0xf, 0xf, true)))
DI float sum16(float v) {
  v = DPP_ADD(v, 0xB1);
  v = DPP_ADD(v, 0x4E);
  v = DPP_ADD(v, 0x141);
  v = DPP_ADD(v, 0x140);
  return v;
}
DI float wave_sum(float v) {
  v = sum16(v);
  v += __shfl_xor(v, 16);
  v += __shfl_xor(v, 32);
  return v;
}

namespace pg8 {
#define PG8_LAS __attribute__((address_space(3)))
typedef unsigned short bf16_t;
typedef short bf16x8 __attribute__((ext_vector_type(8)));
typedef float f32x4 __attribute__((ext_vector_type(4)));
typedef unsigned u32x4 __attribute__((ext_vector_type(4)));
constexpr int BM = 256, BK = 64, HALF = 128, HTB = HALF * BK * 2  , STAGE_BYTES = 8 * HTB, NXCD = 8, WGM = 8;

__host__ __device__ __forceinline__ int lds_byte(int r, int c) { const int st = (r >> 4) * 2 + (c >> 5), rr = r & 15, cc = c & 31, ob = rr * 64 + cc * 2; return st * 1024 + (ob ^ (((ob >> 9) & 1) << 5)); }
__host__ __device__ __forceinline__ void stage_rc(int b, int& R, int& C) { const int st = b / 1024, sb = b % 1024, swz = sb ^ (((sb >> 9) & 1) << 5); R = (st >> 1) * 16 + swz / 64; C = (st & 1) * 32 + (swz % 64) / 2; }
__host__ __device__ __forceinline__ int perm32(int rho) { const int n = rho >> 4, i = rho & 15; return 8 * (i >> 2) + 4 * n + (i & 3); }

struct Unit { int pm, pn; };
struct Gemm { const bf16_t* A; const bf16_t* Bt; int M, N, K; };

struct StaticOrder {
    int nM, nN, nwg, G, c;
    __host__ __device__ void init(int M, int N, int G_, int c_) { nM = M / BM; nN = N / BM; nwg = nM * nN; G = G_; c = c_; }
    __host__ __device__ bool next(int i, Unit& u) const {
        const long L = (long)i * G + c; if (L >= nwg) return false;
        int wgid = (int)L; { const int q = nwg / NXCD, r = nwg % NXCD, xcd = wgid % NXCD, off = wgid / NXCD; wgid = (xcd < r ? xcd * (q + 1) : r * (q + 1) + (xcd - r) * q) + off; }
        const int nig = WGM * nN, gid = wgid / nig, fm = gid * WGM, gsz = (nM - fm) < WGM ? (nM - fm) : WGM;
        u.pm = fm + ((wgid % nig) % gsz); u.pn = (wgid % nig) / gsz; return true;
    }
    __device__ __forceinline__ void a_ready(const Unit&) const {}
    __device__ __forceinline__ void done(const Unit&) const {}
};
__device__ __forceinline__ unsigned cvt_pk_bf16(float lo, float hi) { unsigned r; asm volatile("v_cvt_pk_bf16_f32 %0, %1, %2" : "=v"(r) : "v"(lo), "v"(hi)); return r; }
typedef float f32x2 __attribute__((ext_vector_type(2)));
template <class Epi, class Sched>
__device__ __forceinline__ void gemm_phase(PG8_LAS unsigned char* lds, const Gemm g, const Sched& S, const Epi& E) {
    const int tid = ltid(), wid = __builtin_amdgcn_readfirstlane(tid >> 6), lane = tid & 63, wr = wid >> 2, wc = wid & 3, fr = lane & 15, fq = lane >> 4;
    const int K = g.K, nt = K / BK;
    unsigned voffA[2], voffB[2];
#pragma unroll
    for (int i = 0; i < 2; ++i) { int R, C; stage_rc(tid * 16 + i * 8192, R, C); const int Rb = Epi::PERM ? ((R & ~31) + perm32(R & 31)) : R;
        voffA[i] = (unsigned)(R * K + C) * 2u; voffB[i] = (unsigned)(Rb * K + C) * 2u; }
    const size_t kstep = (size_t)(BK * 2);
    const size_t hstep = (size_t)HALF * K * 2;
    const size_t tstep = 2 * hstep;
    const unsigned ldsw = (unsigned)wid * 1024u;
    const int aoff = lds_byte(wr * 64 + fr, fq * 8), boff = lds_byte(wc * 32 + fr, fq * 8);
#define PG8_SA(b, h) (((b) * 2 + (h)) * HTB)
#define PG8_SB(b, h) ((4 + (b) * 2 + (h)) * HTB)
#define PG8_STAGE(bufoff, gbase, voff) do { _Pragma("unroll") for (int _i = 0; _i < 2; ++_i) \
        __builtin_amdgcn_global_load_lds((const unsigned*)((const char*)(gbase) + (voff)[_i]), (PG8_LAS unsigned*)(lds + (bufoff) + ldsw + _i * 8192), 16, 0, 0); } while (0)
#define PG8_LDA(dst, b, h) do { _Pragma("unroll") for (int m = 0; m < 4; ++m) _Pragma("unroll") for (int k = 0; k < 2; ++k) dst[m][k] = *(const PG8_LAS bf16x8*)(lds + PG8_SA(b, h) + aoff + m * 2048 + k * 1024); } while (0)
#define PG8_LDB(dst, b, h) do { _Pragma("unroll") for (int n = 0; n < 2; ++n) _Pragma("unroll") for (int k = 0; k < 2; ++k) dst[n][k] = *(const PG8_LAS bf16x8*)(lds + PG8_SB(b, h) + boff + n * 2048 + k * 1024); } while (0)
#define PG8_MMA(ai, bj, At, Bt) do { __builtin_amdgcn_s_setprio(1); _Pragma("unroll") for (int m = 0; m < 4; ++m) _Pragma("unroll") for (int n = 0; n < 2; ++n) _Pragma("unroll") for (int k = 0; k < 2; ++k) \
        acc[ai][bj][m][n] = __builtin_amdgcn_mfma_f32_16x16x32_bf16(Bt[n][k], At[m][k], acc[ai][bj][m][n], 0, 0, 0); __builtin_amdgcn_s_setprio(0); } while (0)
#define PG8_WAIT_V(n) asm volatile("s_waitcnt vmcnt(" #n ")" ::: "memory")
#define PG8_WAIT_L(n) asm volatile("s_waitcnt lgkmcnt(" #n ")" ::: "memory")
#define PG8_BAR __builtin_amdgcn_s_barrier()
#define PG8_SCHED __builtin_amdgcn_sched_barrier(0)
    Unit cur, nxt; int ui = 0;
    if (!S.next(0, cur)) return;
    f32x4 acc[2][2][4][2];
#pragma unroll
    for (int a = 0; a < 2; ++a)
#pragma unroll
        for (int b = 0; b < 2; ++b)
#pragma unroll
            for (int m = 0; m < 4; ++m)
#pragma unroll
                for (int n = 0; n < 2; ++n) acc[a][b][m][n] = (f32x4){0.f, 0.f, 0.f, 0.f};
    bf16x8 At[4][2], B0[2][2], B1[2][2];
    const char* cA = (const char*)g.A + (size_t)cur.pm * tstep; const char* cB = (const char*)g.Bt + (size_t)cur.pn * tstep;
    S.a_ready(cur);
    PG8_STAGE(PG8_SB(0, 0), cB, voffB); PG8_STAGE(PG8_SA(0, 0), cA, voffA); PG8_STAGE(PG8_SB(0, 1), cB + hstep, voffB); PG8_STAGE(PG8_SA(0, 1), cA + hstep, voffA);
    if (wr == 1) PG8_BAR;
    PG8_WAIT_V(4); PG8_BAR;
    PG8_STAGE(PG8_SB(1, 0), cB + kstep, voffB); PG8_STAGE(PG8_SA(1, 0), cA + kstep, voffA); PG8_STAGE(PG8_SB(1, 1), cB + hstep + kstep, voffB);
    PG8_WAIT_V(6); PG8_BAR;
    for (;;) {
        const bool has_next = S.next(ui + 1, nxt);
        const char* nA = has_next ? (const char*)g.A + (size_t)nxt.pm * tstep : cA; const char* nB = has_next ? (const char*)g.Bt + (size_t)nxt.pn * tstep : cB;
        for (int t = 0; t < nt; t += 2) {
            const bool last = (t == nt - 2);
            const char* a1 = cA + (size_t)(t + 1) * kstep;
            const char* a2 = last ? nA : cA + (size_t)(t + 2) * kstep; const char* b2 = last ? nB : cB + (size_t)(t + 2) * kstep;
            const char* a3 = a2 + kstep; const char* b3 = b2 + kstep;
            if (last && has_next) S.a_ready(nxt);
            PG8_LDB(B0, 0, 0); PG8_SCHED; PG8_LDA(At, 0, 0); PG8_STAGE(PG8_SA(1, 1), a1 + hstep, voffA);
            PG8_WAIT_L(8); PG8_BAR; PG8_WAIT_L(0); PG8_MMA(0, 0, At, B0); PG8_BAR; PG8_SCHED;
            PG8_LDB(B1, 0, 1); PG8_STAGE(PG8_SB(0, 0), b2, voffB);
            PG8_BAR; PG8_WAIT_L(0); PG8_MMA(0, 1, At, B1); PG8_BAR;
            PG8_LDA(At, 0, 1); PG8_STAGE(PG8_SA(0, 0), a2, voffA);
            PG8_BAR; PG8_WAIT_L(0); PG8_MMA(1, 0, At, B0); PG8_BAR; PG8_SCHED;
            PG8_STAGE(PG8_SB(0, 1), b2 + hstep, voffB);
            PG8_WAIT_V(6); PG8_BAR; PG8_MMA(1, 1, At, B1); PG8_BAR;
            PG8_LDB(B0, 1, 0); PG8_SCHED; PG8_LDA(At, 1, 0); PG8_STAGE(PG8_SA(0, 1), a2 + hstep, voffA);
            PG8_WAIT_L(8); PG8_BAR; PG8_WAIT_L(0); PG8_MMA(0, 0, At, B0); PG8_BAR; PG8_SCHED;
            PG8_LDB(B1, 1, 1); PG8_STAGE(PG8_SB(1, 0), b3, voffB);
            PG8_BAR; PG8_WAIT_L(0); PG8_MMA(0, 1, At, B1); PG8_BAR;
            PG8_LDA(At, 1, 1); PG8_STAGE(PG8_SA(1, 0), a3, voffA);
            PG8_BAR; PG8_WAIT_L(0); PG8_MMA(1, 0, At, B0); PG8_BAR; PG8_SCHED;
            PG8_STAGE(PG8_SB(1, 1), b3 + hstep, voffB);
            PG8_WAIT_V(6); PG8_BAR; PG8_MMA(1, 1, At, B1); PG8_BAR;
        }
        if constexpr (!Epi::AFTER_DRAIN) { E(acc, cur, wr, wc, fr, fq); S.done(cur); }
        if (!has_next) break;
#pragma unroll
        for (int a = 0; a < 2; ++a)
#pragma unroll
            for (int b = 0; b < 2; ++b)
#pragma unroll
                for (int m = 0; m < 4; ++m)
#pragma unroll
                    for (int n = 0; n < 2; ++n) acc[a][b][m][n] = (f32x4){0.f, 0.f, 0.f, 0.f};
        cur = nxt; cA = nA; cB = nB; ++ui;
    }
    PG8_WAIT_V(0);
    if (wr == 0) PG8_BAR;
    PG8_BAR;
    if constexpr (Epi::AFTER_DRAIN) { E.fused(acc, cur, wr, wc, fr, fq, lds, wid, lane); S.done(cur); }
#undef PG8_SA
#undef PG8_SB
#undef PG8_STAGE
#undef PG8_LDA
#undef PG8_LDB
#undef PG8_MMA
#undef PG8_WAIT_V
#undef PG8_WAIT_L
#undef PG8_BAR
#undef PG8_SCHED
}
}

#include <cstdint>
#define XB_TMO      128
#define XB_XCNT(j)  (256  + 64 * (j))
#define XB_XSUB(j)  (1280 + 64 * (j))
#define XB_XGEN(j)  (2304 + 64 * (j))
#define XB_TOP      3328
#define XB_TOPGEN   3392
#define XCD_BAR_WORDS 3456
#define XB_SPIN_CAP (1u << 18)
#define LAS __attribute__((address_space(3)))

__device__ __forceinline__ unsigned xb_ld(unsigned* p)              { return __hip_atomic_load(p, __ATOMIC_RELAXED, __HIP_MEMORY_SCOPE_AGENT); }
__device__ __forceinline__ unsigned xb_add(unsigned* p, unsigned v) { return __hip_atomic_fetch_add(p, v, __ATOMIC_RELAXED, __HIP_MEMORY_SCOPE_AGENT); }
__device__ __forceinline__ unsigned xb_xcc_id() { return (unsigned)__builtin_amdgcn_s_getreg((3 << 11) | 20) & 0xFu; }
#define XB_SPIN(cond, bar) do { unsigned _sp = 0; while (cond) { __builtin_amdgcn_s_sleep(1); \
    if ((++_sp & 255u) == 0u) { if (xb_ld(&(bar)[XB_TMO])) break; if (_sp > XB_SPIN_CAP) { atomicAdd(&(bar)[XB_TMO], 1u); break; } } } } while (0)

struct XcdBarrier {
    unsigned* bar; unsigned x;
    volatile LAS unsigned* st;
};

__device__ __forceinline__ XcdBarrier xcd_barrier_post(unsigned* bar, volatile LAS unsigned* st) {
    XcdBarrier b; b.bar = bar; b.x = xb_xcc_id(); b.st = st;
    if (threadIdx.x == 0) (void)xb_add(&bar[XB_XCNT(b.x)], 1u);
    return b;
}
__device__ __forceinline__ void xcd_barrier_complete(unsigned* bar, unsigned x, unsigned& nloc, unsigned& nx) {
    const unsigned G = gridDim.x * gridDim.y * gridDim.z;
    unsigned sum, cnt, mine, sp = 0u;
    for (;;) {
        sum = 0u; cnt = 0u; mine = 0u;
#pragma unroll
        for (unsigned j = 0; j < 16; ++j) { const unsigned c = xb_ld(&bar[XB_XCNT(j)]); sum += c; cnt += (c > 0u) ? 1u : 0u; mine = (j == x) ? c : mine; }
        if (sum == G) break;
        __builtin_amdgcn_s_sleep(1);
        if ((++sp & 255u) == 0u) { if (xb_ld(&bar[XB_TMO])) break; if (sp > XB_SPIN_CAP) { atomicAdd(&bar[XB_TMO], 1u); break; } }
    }
    nloc = mine > 0u ? mine : 1u; nx = cnt > 0u ? cnt : 1u;
}

__device__ __forceinline__ void xcd_barrier(const XcdBarrier& b) {
    asm volatile("s_waitcnt vmcnt(0)" ::: "memory");
    __syncthreads();
    if (threadIdx.x == 0) {
        unsigned* bar = b.bar;
        __builtin_amdgcn_s_waitcnt(0);
        unsigned nloc = b.st[0], nx = b.st[1];
        if (nloc == 0u) { xcd_barrier_complete(bar, b.x, nloc, nx); b.st[0] = nloc; b.st[1] = nx; }
        const unsigned old = xb_add(&bar[XB_XSUB(b.x)], 1u);
        const unsigned gen = old / nloc;
        if (old + 1u == (gen + 1u) * nloc) {
            __builtin_amdgcn_fence(__ATOMIC_RELEASE, "agent");
            asm volatile("s_waitcnt vmcnt(0)" ::: "memory");
            const unsigned og = xb_add(&bar[XB_TOP], 1u);
            const unsigned tg = og / nx;
            if (og + 1u == (tg + 1u) * nx) xb_add(&bar[XB_TOPGEN], 1u);
            else XB_SPIN(xb_ld(&bar[XB_TOPGEN]) == tg, bar);
            __builtin_amdgcn_fence(__ATOMIC_ACQUIRE, "agent");
            xb_add(&bar[XB_XGEN(b.x)], 1u);
            asm volatile("s_waitcnt vmcnt(0)" ::: "memory");
        } else {
            XB_SPIN(xb_ld(&bar[XB_XGEN(b.x)]) == gen, bar);
            __builtin_amdgcn_fence(__ATOMIC_ACQUIRE, "agent");
            asm volatile("s_waitcnt vmcnt(0)" ::: "memory");
        }
    }
    __syncthreads();
}

typedef pg8::f32x4 a4_t;
DI u32x4 pack8(const a4_t& v0, const a4_t& v1) {
  u32x4 w = {pk2(v0[0], v0[1]), pk2(v0[2], v0[3]), pk2(v1[0], v1[1]), pk2(v1[2], v1[3])};
  return w;
}
DI void unpack8(const u32x4& g, a4_t& g0, a4_t& g1) {
  g0[0] = bflo(g[0]); g0[1] = bfhi(g[0]); g0[2] = bflo(g[1]); g0[3] = bfhi(g[1]);
  g1[0] = bflo(g[2]); g1[1] = bfhi(g[2]); g1[2] = bflo(g[3]); g1[3] = bfhi(g[3]);
}

struct EpiYT {
  static constexpr bool PERM = true, AFTER_DRAIN = false;
  u16* YT;
  DI void operator()(const a4_t (&acc)[2][2][4][2], const pg8::Unit& u, int wr, int wc, int fr, int fq) const {
    const int row0 = u.pm * 256 + wr * 64 + fr;
    const int b = u.pn >> 4;
    const int n0 = (u.pn & 15) * 256 + wc * 32 + 8 * fq;
#pragma unroll
    for (int ai = 0; ai < 2; ++ai)
#pragma unroll
      for (int m = 0; m < 4; ++m) {
        const int row = row0 + ai * 128 + m * 16;
        u16* rowp = YT + ((size_t)(b * 512 + (row & 511))) * 8192 + (row >> 9) * 4096 + n0;
#pragma unroll
        for (int bj = 0; bj < 2; ++bj) *(u32x4*)(rowp + bj * 128) = pack8(acc[ai][bj][m][0], acc[ai][bj][m][1]);
      }
  }
};

struct EpiQKV {
  static constexpr bool PERM = true, AFTER_DRAIN = false;
  u16* QKV; float* BD;
  DI void operator()(const a4_t (&acc)[2][2][4][2], const pg8::Unit& u, int wr, int wc, int fr, int fq) const {
    const int row0 = u.pm * 256 + wr * 64 + fr;
    if (u.pn < 12) {
      const int col0 = u.pn * 256 + wc * 32 + 8 * fq;
#pragma unroll
      for (int ai = 0; ai < 2; ++ai)
#pragma unroll
        for (int m = 0; m < 4; ++m) {
          u16* rowp = QKV + (size_t)(row0 + ai * 128 + m * 16) * 3072 + col0;
#pragma unroll
          for (int bj = 0; bj < 2; ++bj) *(u32x4*)(rowp + bj * 128) = pack8(acc[ai][bj][m][0], acc[ai][bj][m][1]);
        }
    } else if (wc == 0) {
#pragma unroll
      for (int ai = 0; ai < 2; ++ai)
#pragma unroll
        for (int m = 0; m < 4; ++m) {
          float* rowp = BD + (size_t)(row0 + ai * 128 + m * 16) * 32 + 8 * fq;
          *(a4_t*)(rowp) = acc[ai][0][m][0];
          *(a4_t*)(rowp + 4) = acc[ai][0][m][1];
        }
    }
  }
};

struct EpiDFT {
  static constexpr bool PERM = true, AFTER_DRAIN = false;
  u16* MIXED;
  DI void operator()(const a4_t (&acc)[2][2][4][2], const pg8::Unit& u, int wr, int wc, int fr, int fq) const {
    const int row0 = u.pm * 256 + wr * 64 + fr;
    const int b = u.pn >> 1;
    const int col0 = (u.pn & 1) * 256 + wc * 32 + 8 * fq;
    const float sc = 0.0013810679320049757f;
#pragma unroll
    for (int ai = 0; ai < 2; ++ai)
#pragma unroll
      for (int m = 0; m < 4; ++m) {
        u16* rowp = MIXED + ((size_t)(b * 4096 + row0 + ai * 128 + m * 16)) * 512 + col0;
#pragma unroll
        for (int bj = 0; bj < 2; ++bj) *(u32x4*)(rowp + bj * 128) = pack8(acc[ai][bj][m][0] * sc, acc[ai][bj][m][1] * sc);
      }
  }
};

struct EpiGates {
  static constexpr bool PERM = true, AFTER_DRAIN = false;
  u16* GATES;
  DI void operator()(const a4_t (&acc)[2][2][4][2], const pg8::Unit& u, int wr, int wc, int fr, int fq) const {
    const int row0 = u.pm * 256 + wr * 64 + fr;
    const int col0 = u.pn * 256 + wc * 32 + 8 * fq;
    const bool is_silu = u.pn < 6;
#pragma unroll
    for (int ai = 0; ai < 2; ++ai)
#pragma unroll
      for (int m = 0; m < 4; ++m) {
        u16* rowp = GATES + (size_t)(row0 + ai * 128 + m * 16) * 3584 + col0;
#pragma unroll
        for (int bj = 0; bj < 2; ++bj) {
          a4_t v0 = acc[ai][bj][m][0], v1 = acc[ai][bj][m][1];
#pragma unroll
          for (int j = 0; j < 4; ++j) {
            const float s0 = sigm_f(v0[j]), s1 = sigm_f(v1[j]);
            v0[j] = is_silu ? v0[j] * s0 : s0;
            v1[j] = is_silu ? v1[j] * s1 : s1;
          }
          *(u32x4*)(rowp + bj * 128) = pack8(v0, v1);
        }
      }
  }
};

struct EpiGated {
  static constexpr bool PERM = true, AFTER_DRAIN = false;
  u16* OUT; int ldo; const u16* GATES; int gcol0; const u16* ADD;
  DI void operator()(const a4_t (&acc)[2][2][4][2], const pg8::Unit& u, int wr, int wc, int fr, int fq) const {
    const int row0 = u.pm * 256 + wr * 64 + fr;
    const int col0 = u.pn * 256 + wc * 32 + 8 * fq;
#pragma unroll
    for (int ai = 0; ai < 2; ++ai) {
      u32x4 g[4][2], ad[4][2];
#pragma unroll
      for (int m = 0; m < 4; ++m)
#pragma unroll
        for (int bj = 0; bj < 2; ++bj) {
          const size_t row = (size_t)(row0 + ai * 128 + m * 16);
          const int col = col0 + bj * 128;
          g[m][bj] = *(const u32x4*)(GATES + row * 3584 + gcol0 + col);
          if (ADD) ad[m][bj] = *(const u32x4*)(ADD + row * ldo + col);
        }
      __builtin_amdgcn_sched_barrier(0);
#pragma unroll
      for (int m = 0; m < 4; ++m)
#pragma unroll
        for (int bj = 0; bj < 2; ++bj) {
          const size_t row = (size_t)(row0 + ai * 128 + m * 16);
          const int col = col0 + bj * 128;
          a4_t g0, g1;
          unpack8(g[m][bj], g0, g1);
          a4_t v0 = acc[ai][bj][m][0] * g0, v1 = acc[ai][bj][m][1] * g1;
          if (ADD) {
            a4_t d0, d1;
            unpack8(ad[m][bj], d0, d1);
            v0 += d0; v1 += d1;
          }
          *(u32x4*)(OUT + row * ldo + col) = pack8(v0, v1);
        }
      asm volatile("" ::: "memory");
    }
  }
};

struct EpiOut {
  static constexpr bool PERM = false, AFTER_DRAIN = false;
  float* OUT; const float* X; const float* POS; const float* MOD;
  DI void operator()(const a4_t (&acc)[2][2][4][2], const pg8::Unit& u, int wr, int wc, int fr, int fq) const {
    const int row0 = u.pm * 256 + wr * 64 + fr;
    const int col0 = u.pn * 256 + wc * 32 + 4 * fq;
    const int b = u.pm >> 4;
    a4_t gv[2][2];
#pragma unroll
    for (int bj = 0; bj < 2; ++bj)
#pragma unroll
      for (int n = 0; n < 2; ++n) gv[bj][n] = *(const a4_t*)(MOD + b * 3072 + 2048 + col0 + bj * 128 + n * 16);
#pragma unroll
    for (int ai = 0; ai < 2; ++ai)
#pragma unroll
      for (int m = 0; m < 4; ++m) {
        const int row = row0 + ai * 128 + m * 16;
        const int nn = row & 4095, pr = nn >> 6, pc = nn & 63;
        const float* prow = (u.pn < 2) ? (POS + pr * 512 + col0) : (POS + 32768 + pc * 512 + (col0 - 512));
        const size_t off = (size_t)row * 1024 + col0;
#pragma unroll
        for (int bj = 0; bj < 2; ++bj)
#pragma unroll
          for (int n = 0; n < 2; ++n) {
            const a4_t xv = *(const a4_t*)(X + off + bj * 128 + n * 16);
            const a4_t pe = *(const a4_t*)(prow + bj * 128 + n * 16);
            *(a4_t*)(OUT + off + bj * 128 + n * 16) = (xv + pe) * 1.189207115002721f + gv[bj][n] * acc[ai][bj][m][n];
          }
        asm volatile("" ::: "memory");
      }
  }
};

struct EpiGateOut {
  static constexpr bool PERM = true, AFTER_DRAIN = false;
  u16* G; const float* MOD;
  DI void operator()(const a4_t (&acc)[2][2][4][2], const pg8::Unit& u, int wr, int wc, int fr, int fq) const {
    const int row0 = u.pm * 256 + wr * 64 + fr;
    const int col0 = u.pn * 256 + wc * 32 + 8 * fq;
    const int b = u.pm >> 4;
    a4_t gv[2][2];
#pragma unroll
    for (int bj = 0; bj < 2; ++bj)
#pragma unroll
      for (int n = 0; n < 2; ++n) gv[bj][n] = *(const a4_t*)(MOD + b * 3072 + 2048 + col0 + bj * 128 + 4 * n);
#pragma unroll
    for (int ai = 0; ai < 2; ++ai)
#pragma unroll
      for (int m = 0; m < 4; ++m) {
        u16* rowp = G + (size_t)(row0 + ai * 128 + m * 16) * 1024 + col0;
#pragma unroll
        for (int bj = 0; bj < 2; ++bj) *(u32x4*)(rowp + bj * 128) = pack8(acc[ai][bj][m][0] * gv[bj][0], acc[ai][bj][m][1] * gv[bj][1]);
      }
  }
};

template <class Epi>
DI void run_gemm(unsigned char* smem, const u16* A, const u16* Bt, int M, int N, int K, const Epi& E) {
  pg8::Gemm g;
  g.A = A; g.Bt = Bt; g.M = M; g.N = N; g.K = K;
  pg8::StaticOrder S;
  S.init(M, N, (int)gridDim.x, (int)blockIdx.x);
  pg8::gemm_phase<Epi, pg8::StaticOrder>((PG8_LAS unsigned char*)smem, g, S, E);
  __syncthreads();
}

DI void transpose_task(const float* __restrict__ src, int ld, int col0, int k0, u16* dst, int ldd, char* smem, int t) {
  float* ts = (float*)smem;
  {
    const int c = t & 31, kr = t >> 5;
    float rv[8];
#pragma unroll
    for (int p = 0; p < 8; ++p) rv[p] = (col0 >= 0) ? src[(size_t)(k0 + kr + 8 * p) * ld + col0 + c] : 0.f;
#pragma unroll
    for (int p = 0; p < 8; ++p) ts[(kr + 8 * p) * 33 + c] = rv[p];
  }
  __syncthreads();
  {
    const int wr = t >> 3, kc = t & 7;
    u32x4 v;
#pragma unroll
    for (int e = 0; e < 4; ++e) v[e] = pk2(ts[(kc * 8 + 2 * e) * 33 + wr], ts[(kc * 8 + 2 * e + 1) * 33 + wr]);
    *(u32x4*)(dst + (size_t)wr * ldd + k0 + kc * 8) = v;
  }
  __syncthreads();
}

DI void transpose_task4(const float* __restrict__ src, int ld, int col0, int k0, u16* dst, int ldd, char* smem, int t) {
  float* ts = (float*)smem;
  {
    const int c = t & 31, kr = t >> 5;
#pragma unroll 1
    for (int pb = 0; pb < 32; pb += 16) {
      float rv[16];
#pragma unroll
      for (int p = 0; p < 16; ++p) rv[p] = (col0 >= 0) ? src[(size_t)(k0 + kr + 8 * (pb + p)) * ld + col0 + c] : 0.f;
#pragma unroll
      for (int p = 0; p < 16; ++p) ts[(kr + 8 * (pb + p)) * 33 + c] = rv[p];
    }
  }
  __syncthreads();
  {
    const int wr = t >> 3, kc = t & 7;
#pragma unroll
    for (int q = 0; q < 4; ++q) {
      u32x4 v;
#pragma unroll
      for (int e = 0; e < 4; ++e) v[e] = pk2(ts[(q * 64 + kc * 8 + 2 * e) * 33 + wr], ts[(q * 64 + kc * 8 + 2 * e + 1) * 33 + wr]);
      *(u32x4*)(dst + (size_t)wr * ldd + k0 + q * 64 + kc * 8) = v;
    }
  }
  __syncthreads();
}

DI int wt1_srccol(int row) {
  if (row < 4096) return row;
  if (row < 4128) return 5120 + (row - 4096);
  if (row < 4352) return -1;
  if (row < 4864) return 512 + (row - 4352);
  if (row < 5888) return 4096 + (row - 4864);
  return 5152 + (row - 5888);
}

DI void phase_prep(const Params& P, char* smem_all, int first_kind) {
  const int tt = ltid();
  const int half = tt >> 8, t = tt & 255;
  char* smem = smem_all + half * HALF_SMEM;
  u16* WT1 = (u16*)(P.ws + OFF_WT1);
  constexpr int T_IN = 216 * 4;
  constexpr int T_FOUT = 32 * 2, T_DN = 32 * 4, T_OUT = 32 * 4, T_FMIX = 16 * 8, T_FOLD = 1024, T_TRIG = 512, T_POS = 32,
                T_MOD = 96;
  constexpr int B1 = T_IN, B2 = B1 + T_FOUT, B3 = B2 + T_DN, B4 = B3 + T_OUT, B5 = B4 + T_FMIX, B6 = B5 + T_FOLD,
                B7 = B6 + T_TRIG, B8 = B7 + T_POS, B9 = B8 + T_MOD;
  bool tab_built = false;
  const int t_lo = first_kind == 0 ? B7 : 0, t_hi = first_kind == 0 ? B9 : B7;
  for (int task0 = t_lo + blockIdx.x * 2; task0 < t_hi; task0 += gridDim.x * 2) {
    const int task = task0 + half;
    if (task < B1) {
      const int rt = task >> 2, kt = task & 3;
      const int row0 = 1024 + rt * 32;
      transpose_task4(P.w_in, 7200, wt1_srccol(row0), kt * 256, WT1 + (size_t)row0 * 1024, 1024, smem, t);
    } else if (task < B2) {
      const int id = task - B1, rt = id >> 1, kt = id & 1;
      transpose_task4(P.w_f_out, 1024, rt * 32, kt * 256, (u16*)(P.ws + OFF_WFOUT) + (size_t)(rt * 32) * 512, 512, smem, t);
    } else if (task < B3) {
      const int id = task - B2, rt = id >> 2, kt = id & 3;
      transpose_task4(P.w_dn_out, 1024, rt * 32, kt * 256, (u16*)(P.ws + OFF_WDN) + (size_t)(rt * 32) * 1024, 1024, smem, t);
    } else if (task < B4) {
      const int id = task - B3, rt = id >> 2, kt = id & 3;
      transpose_task4(P.w_out, 1024, rt * 32, kt * 256, (u16*)(P.ws + OFF_WOUT) + (size_t)(rt * 32) * 1024, 1024, smem, t);
    } else if (task < B5) {
      const int id = task - B4, rt = id >> 3, kt = id & 7;
      const int g = rt >> 2;
      u16* W = (u16*)(P.ws + OFF_WFMIX);
      if ((kt >> 1) == g)
        transpose_task(P.w_fmix + (size_t)g * 16384, 128, (rt & 3) * 32, (kt & 1) * 64, W + (size_t)(rt * 32) * 512 + g * 128, 512, smem, t);
      else
        transpose_task(P.w_fmix, 128, -1, kt * 64, W + (size_t)(rt * 32) * 512, 512, smem, t);
    } else if (task < B6) {
      const int id = task - B5, which = id >> 9, mblk = (id >> 4) & 31, dblk = id & 15;
      const int g = mblk >> 3;
      const int d0 = dblk * 64;
      float* Wsm = (float*)smem;
      float* tab = Wsm + 64 * 129;
#pragma unroll 1
      for (int ib = 0; ib < 32; ib += 8) {
        float rv[8];
#pragma unroll
        for (int q = 0; q < 8; ++q) { const int idx = t + 256 * (ib + q); rv[q] = P.w_in[(size_t)(d0 + (idx >> 7)) * 7200 + g * 128 + (idx & 127)]; }
#pragma unroll
        for (int q = 0; q < 8; ++q) { const int idx = t + 256 * (ib + q); Wsm[(idx >> 7) * 129 + (idx & 127)] = rv[q]; }
      }
      if (t < 128) tab[t] = which ? sinpif((float)t * (1.f / 64.f)) : cospif((float)t * (1.f / 64.f));
      __syncthreads();
      const int d = t & 63, mg = t >> 6;
      float* Cm = tab + 128;
#pragma unroll
      for (int e = 0; e < 4; ++e) {
        const int m = (mblk & 7) * 16 + mg * 4 + e;
        Cm[(mg * 4 + e) * 128 + d] = tab[(m * d) & 127];
        Cm[(mg * 4 + e) * 128 + 64 + d] = tab[(m * (64 + d)) & 127];
      }
      __syncthreads();
      float acc[4] = {0.f, 0.f, 0.f, 0.f};
#pragma unroll 2
      for (int c0 = 0; c0 < 128; c0 += 8) {
        float wv[8];
#pragma unroll
        for (int k = 0; k < 8; ++k) wv[k] = Wsm[d * 129 + c0 + k];
        f32x4 cl[4], ch[4];
#pragma unroll
        for (int e = 0; e < 4; ++e) {
          cl[e] = *(const f32x4*)(Cm + (mg * 4 + e) * 128 + c0);
          ch[e] = *(const f32x4*)(Cm + (mg * 4 + e) * 128 + c0 + 4);
        }
#pragma unroll
        for (int e = 0; e < 4; ++e) {
          acc[e] += wv[0] * cl[e][0] + wv[1] * cl[e][1] + wv[2] * cl[e][2] + wv[3] * cl[e][3];
          acc[e] += wv[4] * ch[e][0] + wv[5] * ch[e][1] + wv[6] * ch[e][2] + wv[7] * ch[e][3];
        }
      }
#pragma unroll
      for (int e = 0; e < 4; ++e) {
        const int m = (mblk & 7) * 16 + mg * 4 + e;
        WT1[(size_t)(which * 512 + g * 128 + m) * 1024 + d0 + d] = f2bf(acc[e]);
      }
      __syncthreads();
    } else if (task < B7) {
      float* tab = (float*)(smem + 40960);
      if (!tab_built) {
        for (int j = t; j < 4096; j += 256) tab[j] = cospif((float)j * (1.f / 2048.f));
        tab_built = true;
        __syncthreads();
      }
      u16* TRIG = (u16*)P.out + (size_t)4096 * 8192;
      const int id = task - B6;
      for (int rr = 0; rr < 8; ++rr) {
        const int k = id * 8 + rr;
#pragma unroll
        for (int p = 0; p < 2; ++p) {
          const int chunk = t + 256 * p;
          const int j0 = chunk * 8;
          float v[8];
#pragma unroll
          for (int e = 0; e < 8; ++e) {
            const int j = j0 + e;
            const int idx = (j <= 2048) ? ((k * j) & 4095) : ((k * (j - 2048) - 1024) & 4095);
            v[e] = (j <= 2048) ? tab[idx] : -tab[idx];
          }
          u32x4 o;
#pragma unroll
          for (int e = 0; e < 4; ++e) o[e] = pk2(v[2 * e], v[2 * e + 1]);
          *(u32x4*)(TRIG + (size_t)k * 4096 + j0) = o;
        }
      }
    } else if (task < B8) {
      const int id = task - B7;
      float* POS = (float*)(P.ws + OFF_POS);
#pragma unroll 1
      for (int q = 0; q < 8; ++q) {
        const int e = id * 2048 + q * 256 + t;
        const int p = (e >> 9) & 63, d = e & 511, i = d & 255;
        const float omega = 1.0f / powf(10000.0f, (float)i * (1.f / 256.f));
        const float a = (float)p * omega;
        POS[e] = (d < 256) ? sinf(a) : cosf(a);
      }
    } else {
      const int id = task - B8;
      __syncthreads();
      float* sc = (float*)smem;
#pragma unroll 1
      for (int ib = 0; ib < 36; ib += 12) {
        float rv[12];
#pragma unroll
        for (int q = 0; q < 12; ++q) {
          const int idx = t + 256 * (ib + q);
          const int v = idx >> 10, k = idx & 1023;
          rv[q] = (v < 8) ? P.c[v * 1024 + k] : P.c_ctx[k];
        }
#pragma unroll
        for (int q = 0; q < 12; ++q) sc[t + 256 * (ib + q)] = silu_f(rv[q]);
      }
      __syncthreads();
      const int col = id * 32 + (t & 31), part = t >> 5;
      float a[9];
#pragma unroll
      for (int v = 0; v < 9; ++v) a[v] = 0.f;
#pragma unroll 1
      for (int kb = 0; kb < 128; kb += 16) {
        float wv[16];
#pragma unroll
        for (int q = 0; q < 16; ++q) wv[q] = P.w_mod[(size_t)(part * 128 + kb + q) * 3072 + col];
#pragma unroll
        for (int q = 0; q < 16; ++q)
#pragma unroll
          for (int v = 0; v < 9; ++v) a[v] += sc[v * 1024 + part * 128 + kb + q] * wv[q];
      }
      float* red = (float*)(smem + 40960);
#pragma unroll
      for (int v = 0; v < 9; ++v) red[(part * 9 + v) * 32 + (t & 31)] = a[v];
      __syncthreads();
      {
        float* MOD = (float*)(P.ws + OFF_MOD);
#pragma unroll 1
        for (int o = t; o < 288; o += 256) {
          const int v = o >> 5, cc = o & 31;
          float pr[8];
#pragma unroll
          for (int pp = 0; pp < 8; ++pp) pr[pp] = red[(pp * 9 + v) * 32 + cc];
          float sum = P.b_mod[id * 32 + cc];
#pragma unroll
          for (int pp = 0; pp < 8; ++pp) sum += pr[pp];
          MOD[v * 3072 + id * 32 + cc] = sum;
        }
      }
      __syncthreads();
      tab_built = false;
    }
  }
}

DI void phase_preadd(const Params& P) {
  const int t = ltid();
  const u16* YT = (const u16*)P.out;
  u16* YS = (u16*)P.out + (size_t)4096 * 8192 + (size_t)4096 * 4096;
  const int j0 = t * 8;
  const bool cospart = t < 256;
  const int base_a = cospart ? j0 : (4096 + j0 - 2048);
  const int base_m = cospart ? (4096 - j0) : (8192 - (j0 - 2048));
  const float sgn = cospart ? 1.f : -1.f;
  const bool has_c = (t != 0) && (t != 256);
  for (int it = blockIdx.x; it < 4096; it += gridDim.x) {
    const u16* yr = YT + (size_t)it * 8192;
    const u32x4 A = __builtin_nontemporal_load((const u32x4*)(yr + base_a));
    const u32x4 B = __builtin_nontemporal_load((const u32x4*)(yr + base_m - 8));
    const float c0 = has_c ? bf2f(yr[base_m]) : 0.f;
    const float mid = bf2f(yr[2048]);
    float a[8], m[8];
#pragma unroll
    for (int e = 0; e < 4; ++e) { a[2 * e] = bflo(A[e]); a[2 * e + 1] = bfhi(A[e]); m[2 * e] = bflo(B[e]); m[2 * e + 1] = bfhi(B[e]); }
    float v[8];
    v[0] = a[0] + sgn * c0;
#pragma unroll
    for (int e = 1; e < 8; ++e) v[e] = a[e] + sgn * m[8 - e];
    if (t == 256) v[0] = mid;
    u32x4 o;
#pragma unroll
    for (int e = 0; e < 4; ++e) o[e] = pk2(v[2 * e], v[2 * e + 1]);
    *(u32x4*)(YS + (size_t)it * 4096 + j0) = o;
  }
}

DI void phase_ln_mod(const Params& P) {
  const int t = ltid(), lane = t & 63, w = t >> 6;
  const float* POS = (const float*)(P.ws + OFF_POS);
  const float* MOD = (const float*)(P.ws + OFF_MOD);
  u16* H = (u16*)(P.ws + OFF_H);
  for (int row = blockIdx.x * 8 + w; row < NROWS; row += gridDim.x * 8) {
    const bool lat = row < NLAT;
    const float* src = lat ? (P.x + (size_t)row * 1024) : (P.ctx + (size_t)(row - NLAT) * 1024);
    const int n = row & 4095, pr = n >> 6, pc = n & 63;
    float v[16];
    float4 xa[4], xq[4];
#pragma unroll
    for (int i = 0; i < 4; ++i) {
      const int col = lane * 4 + 256 * i;
      xa[i] = *(const float4*)(src + col);
      xq[i] = *(const float4*)((col < 512) ? (POS + pr * 512 + col) : (POS + 32768 + pc * 512 + (col - 512)));
    }
    __builtin_amdgcn_sched_barrier(0);
    const float pm = lat ? 1.f : 0.f;
#pragma unroll
    for (int i = 0; i < 4; ++i) {
      v[4 * i] = xa[i].x + pm * xq[i].x; v[4 * i + 1] = xa[i].y + pm * xq[i].y;
      v[4 * i + 2] = xa[i].z + pm * xq[i].z; v[4 * i + 3] = xa[i].w + pm * xq[i].w;
    }
    float s = 0.f;
#pragma unroll
    for (int i = 0; i < 16; ++i) s += v[i];
    const float mean = wave_sum(s) * (1.f / 1024.f);
    float q = 0.f;
#pragma unroll
    for (int i = 0; i < 16; ++i) { const float d = v[i] - mean; q += d * d; }
    const float rstd = rsqrtf(wave_sum(q) * (1.f / 1024.f) + 1e-6f);
    const float* mr = MOD + (lat ? (row >> 12) : 8) * 3072;
    float4 shv[4], sclv[4];
#pragma unroll
    for (int i = 0; i < 4; ++i) { shv[i] = *(const float4*)(mr + lane * 4 + 256 * i); sclv[i] = *(const float4*)(mr + 1024 + lane * 4 + 256 * i); }
    __builtin_amdgcn_sched_barrier(0);
#pragma unroll
    for (int i = 0; i < 4; ++i) {
      const int col = lane * 4 + 256 * i;
      const float4 sh = shv[i];
      const float4 scl = sclv[i];
      const float h0 = (v[4 * i] - mean) * rstd * (1.f + scl.x) + sh.x;
      const float h1 = (v[4 * i + 1] - mean) * rstd * (1.f + scl.y) + sh.y;
      const float h2 = (v[4 * i + 2] - mean) * rstd * (1.f + scl.z) + sh.z;
      const float h3 = (v[4 * i + 3] - mean) * rstd * (1.f + scl.w) + sh.w;
      u32x2 o = {pk2(h0, h1), pk2(h2, h3)};
      *(u32x2*)(H + (size_t)row * 1024 + col) = o;
    }
  }
}

DI void lds_barrier() { asm volatile("s_waitcnt lgkmcnt(0)" ::: "memory"); __builtin_amdgcn_s_barrier(); asm volatile("" ::: "memory"); }
DI int tswz(int row, int i) { return row * 72 + ((((i >> 3) ^ ((row >> 3) & 7)) << 3) | (i & 7)); }
DI void prep_unit(const Params& P, int b, int h, int dir, int cs, int isctx, int slot, int cj, char* smem, int t, int solver_w) {
  asm volatile("" : "+v"(t));
  const int lane = t & 63, w = t >> 6;
  const int fr = lane & 31, fh = lane >> 5;
  const int nchunks = isctx ? 4 : 64;
  const int corig = dir ? (nchunks - 1 - cs) : cs;
  const int seqlen = isctx ? 256 : 4096;
  const size_t rowbase = isctx ? (size_t)(NLAT + b * 256) : (size_t)(b * 4096);
  const int r0 = corig * 64;
  const int scan_id = (b * 8 + h) * 2 + dir;
  const u16* QKV = (const u16*)(P.ws + OFF_QKV);
  const float* BD = (const float*)(P.ws + OFF_BD);
  char* blob = P.ws + OFF_OPBUF + (size_t)slot * OPBUF_SLOT + (size_t)(scan_id * 8 + cj) * BLOB;
  u16* q_s = (u16*)(smem);
  u16* k_s = (u16*)(smem + 17408);
  u16* kT_s = (u16*)(smem + 34816);
  u16* vT_s = (u16*)(smem + 53248);
  float* sc = (float*)(smem + 71680);
  float* A_s = (float*)smem;
  u16* Tu_s = (u16*)(smem + 16384);
  u16* Tw_s = (u16*)(smem + 25600);

  float braw = 0.f, draw = 0.f;
  if (w == 0) {
    const int rloc0 = dir ? (63 - lane) : lane;
    const size_t grow = rowbase + r0 + rloc0;
    braw = BD[grow * 32 + dir * 8 + h];
    draw = BD[grow * 32 + 16 + dir * 8 + h];
  }
  {
    const int cg8 = (t & 15) * 8, rg = t >> 4;
    u32x4 xr[3][6];
    f32x4 cw[3][3][2];
#pragma unroll
    for (int part = 0; part < 3; ++part) {
      const int colbase = part * 1024 + h * 128 + cg8;
#pragma unroll
      for (int rr = 0; rr < 6; ++rr) {
        const int r = r0 + rg * 4 - 1 + rr;
        u32x4 v = {0u, 0u, 0u, 0u};
        if (r >= 0 && r < seqlen) v = *(const u32x4*)(QKV + (rowbase + r) * 3072 + colbase);
        xr[part][rr] = v;
      }
#pragma unroll
      for (int tap = 0; tap < 3; ++tap) {
        cw[part][tap][0] = *(const f32x4*)(P.conv_w + tap * 3072 + colbase);
        cw[part][tap][1] = *(const f32x4*)(P.conv_w + tap * 3072 + colbase + 4);
      }
    }
#pragma unroll
    for (int part = 0; part < 3; ++part) {
      float y[4][8];
#pragma unroll
      for (int a = 0; a < 4; ++a) {
        float ss = 0.f;
#pragma unroll
        for (int e = 0; e < 8; ++e) {
          const float x0 = (e & 1) ? bfhi(xr[part][a][e >> 1]) : bflo(xr[part][a][e >> 1]);
          const float x1 = (e & 1) ? bfhi(xr[part][a + 1][e >> 1]) : bflo(xr[part][a + 1][e >> 1]);
          const float x2 = (e & 1) ? bfhi(xr[part][a + 2][e >> 1]) : bflo(xr[part][a + 2][e >> 1]);
          const float z = x0 * cw[part][0][e >> 2][e & 3] + x1 * cw[part][1][e >> 2][e & 3] + x2 * cw[part][2][e >> 2][e & 3];
          y[a][e] = silu_f(z);
          ss += y[a][e] * y[a][e];
        }
        if (part < 2) {
          ss = sum16(ss);
          const float inv = rsqrtf(ss + 1e-6f);
#pragma unroll
          for (int e = 0; e < 8; ++e) y[a][e] *= inv;
        }
        if (part < 2) {
          const int rloc = rg * 4 + a;
          const int i = dir ? (63 - rloc) : rloc;
          u32x4 pv = {pk2(y[a][0], y[a][1]), pk2(y[a][2], y[a][3]), pk2(y[a][4], y[a][5]), pk2(y[a][6], y[a][7])};
          *(u32x4*)((part == 0 ? q_s : k_s) + i * 136 + cg8) = pv;
        }
      }
      if (part >= 1) {
        u16* dstT = (part == 1) ? kT_s : vT_s;
        const int i0 = dir ? (60 - rg * 4) : (rg * 4);
#pragma unroll
        for (int e = 0; e < 8; ++e) {
          const float v0 = dir ? y[3][e] : y[0][e], v1 = dir ? y[2][e] : y[1][e];
          const float v2 = dir ? y[1][e] : y[2][e], v3 = dir ? y[0][e] : y[3][e];
          u32x2 pv = {pk2(v0, v1), pk2(v2, v3)};
          *(u32x2*)(dstT + tswz(cg8 + e, i0)) = pv;
        }
      }
    }
  }
  if (w == 0) {
    const int i = lane;
    const float beta = sigm_f(braw);
    const float xx = draw + P.dt_bias[dir * 8 + h];
    const float sp = (xx > 20.f) ? xx : log1pf(expf(xx));
    float s = -expf(P.a_log[dir * 8 + h]) * sp;
#pragma unroll
    for (int d = 1; d < 64; d <<= 1) {
      const float o = __shfl_up(s, d);
      if (lane >= d) s += o;
    }
    sc[i] = beta;
    sc[64 + i] = s;
  }
  lds_barrier();

  const float gcl = sc[64 + 63];
  f32x16 kk = zero16();
  {
    const int ti = w >> 1, tj = w & 1;
    if (w != 1) {
      bf16x8 fa[8], fb[8];
#pragma unroll
      for (int s8 = 0; s8 < 8; ++s8) {
        fa[s8] = *(const bf16x8*)(k_s + (ti * 32 + fr) * 136 + s8 * 16 + fh * 8);
        fb[s8] = *(const bf16x8*)(k_s + (tj * 32 + fr) * 136 + s8 * 16 + fh * 8);
      }
      __builtin_amdgcn_sched_barrier(0);
#pragma unroll
      for (int s8 = 0; s8 < 8; ++s8) kk = MFMA(fa[s8], fb[s8], kk);
    }
    if (w != 2) {
      const int tj2 = w >> 1, ti2 = w & 1;
      f32x16 qkt = zero16();
      {
        bf16x8 fa[8], fb[8];
#pragma unroll
        for (int s8 = 0; s8 < 8; ++s8) {
          fa[s8] = *(const bf16x8*)(k_s + (tj2 * 32 + fr) * 136 + s8 * 16 + fh * 8);
          fb[s8] = *(const bf16x8*)(q_s + (ti2 * 32 + fr) * 136 + s8 * 16 + fh * 8);
        }
        __builtin_amdgcn_sched_barrier(0);
#pragma unroll
        for (int s8 = 0; s8 < 8; ++s8) qkt = MFMA(fa[s8], fb[s8], qkt);
      }
      const int i = ti2 * 32 + fr;
      const float gci = sc[64 + i];
      f32x16 val;
      float gcj[16];
#pragma unroll
      for (int g = 0; g < 16; ++g) gcj[g] = sc[64 + tj2 * 32 + crow(g, fh)];
#pragma unroll
      for (int g = 0; g < 16; ++g) {
        const int j = tj2 * 32 + crow(g, fh);
        val[g] = (i >= j) ? qkt[g] * 0.08838834764831845f * __expf(gci - gcj[g]) : 0.f;
      }
#pragma unroll
      for (int s = 0; s < 2; ++s) {
        bf16x8 pv = pack_step(val, s);
        __builtin_nontemporal_store((bf16x8)(pv), (bf16x8*)(blob + 49152 + (size_t)((((ti2 * 2 + tj2) * 2 + s) * 64 + lane) * 16)));
      }
    }
  }
#pragma unroll
  for (int p = 0; p < 4; ++p) {
    const int idx = t + 256 * p;
    const int ln = idx & 63, s = (idx >> 6) & 1, tk = (idx >> 7) & 3, ti = idx >> 9;
    const int i = ti * 32 + (ln & 31), hh = ln >> 5;
    const int dk0 = tk * 32 + 16 * s + 4 * hh;
    const u32x2 lo = *(const u32x2*)(q_s + i * 136 + dk0);
    const u32x2 hi = *(const u32x2*)(q_s + i * 136 + dk0 + 8);
    const float sci = 0.08838834764831845f * __expf(sc[64 + i]);
    u32x4 o = {pk2(bflo(lo[0]) * sci, bfhi(lo[0]) * sci), pk2(bflo(lo[1]) * sci, bfhi(lo[1]) * sci),
               pk2(bflo(hi[0]) * sci, bfhi(hi[0]) * sci), pk2(bflo(hi[1]) * sci, bfhi(hi[1]) * sci)};
    __builtin_nontemporal_store((u32x4)(o), (u32x4*)(blob + 16384 + (size_t)idx * 16));
  }
#pragma unroll
  for (int p = 0; p < 4; ++p) {
    const int idx = t + 256 * p;
    const int ln = idx & 63, s = (idx >> 6) & 1, ti = (idx >> 7) & 1, tm = idx >> 8;
    const int dk = tm * 32 + (ln & 31), hh = ln >> 5;
    const int i0 = ti * 32 + 16 * s + 4 * hh;
    const u32x2 lo = *(const u32x2*)(kT_s + tswz(dk, i0));
    const u32x2 hi = *(const u32x2*)(kT_s + tswz(dk, i0 + 8));
    const float4 ga = *(const float4*)(sc + 64 + i0), gb = *(const float4*)(sc + 64 + i0 + 8);
    const float e0 = __expf(gcl - ga.x), e1 = __expf(gcl - ga.y), e2 = __expf(gcl - ga.z), e3 = __expf(gcl - ga.w);
    const float e4 = __expf(gcl - gb.x), e5 = __expf(gcl - gb.y), e6 = __expf(gcl - gb.z), e7 = __expf(gcl - gb.w);
    u32x4 o = {pk2(bflo(lo[0]) * e0, bfhi(lo[0]) * e1), pk2(bflo(lo[1]) * e2, bfhi(lo[1]) * e3),
               pk2(bflo(hi[0]) * e4, bfhi(hi[0]) * e5), pk2(bflo(hi[1]) * e6, bfhi(hi[1]) * e7)};
    __builtin_nontemporal_store((u32x4)(o), (u32x4*)(blob + 32768 + (size_t)idx * 16));
  }
  lds_barrier();

  if (w != 1) {
    const int ti = w >> 1, tj = w & 1;
    const int j = tj * 32 + fr;
    const float gcj = sc[64 + j];
    float bi[16], gi[16];
#pragma unroll
    for (int g = 0; g < 16; ++g) { bi[g] = sc[ti * 32 + crow(g, fh)]; gi[g] = sc[64 + ti * 32 + crow(g, fh)]; }
#pragma unroll
    for (int g = 0; g < 16; ++g) {
      const int i = ti * 32 + crow(g, fh);
      A_s[i * 64 + j] = (i > j) ? bi[g] * kk[g] * __expf(gi[g] - gcj) : 0.f;
    }
  }
  lds_barrier();

  if (w == solver_w) {
    const int cl = lane & 31, hb2 = lane >> 5;
    const float* Ab = A_s + hb2 * (32 * 64 + 32);
    float tt[32];
    {
      float4 Lc[8], Ln[8];
      tt[0] = (cl == 0) ? 1.f : 0.f;
      Lc[0] = *(const float4*)(Ab + 64);
#pragma unroll
      for (int i = 1; i < 32; ++i) {
        if (i + 1 < 32) {
#pragma unroll
          for (int j4 = 0; j4 < (i + 4) / 4; ++j4) Ln[j4] = *(const float4*)(Ab + (i + 1) * 64 + j4 * 4);
        }
        __builtin_amdgcn_sched_barrier(0);
        float s0 = 0.f, s1 = 0.f, s2 = 0.f, s3 = 0.f;
#pragma unroll
        for (int j4 = 0; j4 < (i + 3) / 4; ++j4) {
          const float4 l = Lc[j4];
          if (j4 * 4 + 0 < i) s0 += l.x * tt[j4 * 4 + 0];
          if (j4 * 4 + 1 < i) s1 += l.y * tt[j4 * 4 + 1];
          if (j4 * 4 + 2 < i) s2 += l.z * tt[j4 * 4 + 2];
          if (j4 * 4 + 3 < i) s3 += l.w * tt[j4 * 4 + 3];
        }
        tt[i] = ((cl == i) ? 1.f : 0.f) - ((s0 + s1) + (s2 + s3));
        __builtin_amdgcn_sched_barrier(0);
        if (i + 1 < 32) {
#pragma unroll
          for (int j4 = 0; j4 < (i + 4) / 4; ++j4) Lc[j4] = Ln[j4];
        }
      }
    }
    u16* T11T = (u16*)(smem + 16384);
    u16* T22r = (u16*)(smem + 16384 + 2560);
    if (hb2 == 0) {
#pragma unroll
      for (int q = 0; q < 4; ++q) {
        u32x4 pv = {pk2(tt[8 * q], tt[8 * q + 1]), pk2(tt[8 * q + 2], tt[8 * q + 3]), pk2(tt[8 * q + 4], tt[8 * q + 5]), pk2(tt[8 * q + 6], tt[8 * q + 7])};
        *(u32x4*)(T11T + cl * 40 + 8 * q) = pv;
      }
    } else {
#pragma unroll
      for (int i = 0; i < 32; ++i) T22r[i * 40 + cl] = f2bf(tt[i]);
    }
    asm volatile("s_waitcnt lgkmcnt(0)" ::: "memory");
    f32x16 Pm = zero16();
#pragma unroll
    for (int s2 = 0; s2 < 2; ++s2) {
      const float4 la = *(const float4*)(A_s + (32 + cl) * 64 + 16 * s2 + 8 * hb2);
      const float4 lb = *(const float4*)(A_s + (32 + cl) * 64 + 16 * s2 + 8 * hb2 + 4);
      u32x4 av = {pk2(la.x, la.y), pk2(la.z, la.w), pk2(lb.x, lb.y), pk2(lb.z, lb.w)};
      const bf16x8 bfr = *(const bf16x8*)(T11T + cl * 40 + 16 * s2 + 8 * hb2);
      Pm = MFMA(__builtin_bit_cast(bf16x8, av), bfr, Pm);
    }
    f32x16 Rm = zero16();
#pragma unroll
    for (int s2 = 0; s2 < 2; ++s2) {
      const bf16x8 pb = pack_step(Pm, s2);
      const int k0 = 16 * s2 + 4 * hb2;
      const u32x2 lo = *(const u32x2*)(T22r + cl * 40 + k0);
      const u32x2 hi = *(const u32x2*)(T22r + cl * 40 + k0 + 8);
      u32x4 av = {lo[0], lo[1], hi[0], hi[1]};
      Rm = MFMA(__builtin_bit_cast(bf16x8, av), pb, Rm);
    }
    asm volatile("s_waitcnt lgkmcnt(0)" ::: "memory");
    const float bcA = sc[lane], bgeA = -bcA * __expf(sc[64 + lane]);
    const float bcB = sc[cl], bgeB = -bcB * __expf(sc[64 + cl]);
#pragma unroll
    for (int i = 0; i < 32; ++i) {
      const float top = hb2 ? 0.f : tt[i];
      Tu_s[i * 72 + lane] = f2bf(top * bcA);
      Tw_s[i * 72 + lane] = f2bf(top * bgeA);
    }
    if (hb2) {
#pragma unroll
      for (int i = 0; i < 32; ++i) {
        Tu_s[(32 + i) * 72 + lane] = f2bf(tt[i] * bcA);
        Tw_s[(32 + i) * 72 + lane] = f2bf(tt[i] * bgeA);
      }
    }
#pragma unroll
    for (int g = 0; g < 16; ++g) {
      const int row = 32 + crow(g, hb2);
      Tu_s[row * 72 + cl] = f2bf(-Rm[g] * bcB);
      Tw_s[row * 72 + cl] = f2bf(-Rm[g] * bgeB);
    }
  }
  lds_barrier();

#pragma unroll
  for (int ti = 0; ti < 2; ++ti) {
    f32x16 au = zero16(), aw = zero16();
    {
      bf16x8 f1[4], f2[4], f3[4], f4[4];
#pragma unroll
      for (int s4 = 0; s4 < 4; ++s4) {
        f1[s4] = *(const bf16x8*)(Tu_s + (ti * 32 + fr) * 72 + s4 * 16 + fh * 8);
        f2[s4] = *(const bf16x8*)(vT_s + tswz(w * 32 + fr, s4 * 16 + fh * 8));
        f3[s4] = *(const bf16x8*)(kT_s + tswz(w * 32 + fr, s4 * 16 + fh * 8));
        f4[s4] = *(const bf16x8*)(Tw_s + (ti * 32 + fr) * 72 + s4 * 16 + fh * 8);
      }
      __builtin_amdgcn_sched_barrier(0);
#pragma unroll
      for (int s4 = 0; s4 < 4; ++s4) {
        au = MFMA(f1[s4], f2[s4], au);
        aw = MFMA(f3[s4], f4[s4], aw);
      }
    }
    bf16x8 u0 = pack_step(au, 0), u1 = pack_step(au, 1);
    char* up = blob + 57344 + (size_t)(((ti * 4 + w) * 64 + lane) * 32);
    __builtin_nontemporal_store((bf16x8)(u0), (bf16x8*)(up));
    __builtin_nontemporal_store((bf16x8)(u1), (bf16x8*)(up + 16));
#pragma unroll
    for (int s = 0; s < 2; ++s) {
      bf16x8 pv = pack_step(aw, s);
      __builtin_nontemporal_store((bf16x8)(pv), (bf16x8*)(blob + (size_t)((((ti * 4 + w) * 2 + s) * 64 + lane) * 16)));
    }
  }
  if (t == 0) ((float*)(P.ws + OFF_GL))[(slot * 128 + scan_id) * 8 + cj] = __expf(gcl);
  lds_barrier();
}

DI void prep_segment(const Params& P, int seg, char* smem_all, volatile LAS unsigned* xst) {
  const int tt = ltid();
  const int half = tt >> 8, t = tt & 255;
  char* smem = smem_all + half * HALF_SMEM;
  const int nch = seg == 0 ? 4 : 8;
  const unsigned total_pairs = 64u * nch;
  const bool sharded = (gridDim.x & 7u) == 0u;
  const unsigned shard = sharded ? (blockIdx.x & 7u) : 0u;
  const unsigned per = sharded ? (total_pairs >> 3) : total_pairs;
  unsigned* cnt = (unsigned*)(P.ws + OFF_BAR + 16384) + (seg * 8 + (int)shard) * 64;
  for (;;) {
    if (tt == 0) xst[2] = __hip_atomic_fetch_add(cnt, 1u, __ATOMIC_RELAXED, __HIP_MEMORY_SCOPE_AGENT);
    lds_barrier();
    const unsigned qi = xst[2];
    if (qi >= per) break;
    const unsigned pair = shard * per + qi;
    const int u = (int)pair * 2 + half;
    const int cj = u % nch, sid = u / nch;
    const int b = sid >> 4, h = (sid >> 1) & 7, dir = sid & 1;
    const int cs = seg == 0 ? cj : (seg - 1) * 8 + cj;
    prep_unit(P, b, h, dir, cs, seg == 0, seg & 1, cj, smem, t, half);
  }
}

DI void scan_segment(const Params& P, int seg, char* smem) {
  const int tt = ltid();
  const int half = tt >> 8, t = tt & 255, lane = t & 63, w = t >> 6;
  const int fr = lane & 31, fh = lane >> 5;
  const int sb = blockIdx.x;
  const int b = sb >> 4, h = (sb >> 1) & 7, dir = sb & 1;
  const int nch = seg == 0 ? 4 : 8, slot = seg & 1;
  float* ST = (float*)(P.ws + OFF_STATE) + (size_t)((sb * 4 + w) * 4) * 1024;
  const float* GL = (const float*)(P.ws + OFF_GL) + (slot * 128 + sb) * 8;
  u16* OB = (u16*)P.out + (size_t)dir * NLAT * 1024;
  const char* blob0 = P.ws + OFF_OPBUF + (size_t)slot * OPBUF_SLOT + (size_t)(sb * 8) * BLOB;
  f32x16 S[4];
  u32x4 un[2][2];
  if (half == 0) {
#pragma unroll
    for (int tm = 0; tm < 4; ++tm) {
      if (seg == 0) S[tm] = zero16();
      else {
#pragma unroll
        for (int q = 0; q < 4; ++q) {
          const float4 v = *(const float4*)(ST + tm * 1024 + lane * 16 + q * 4);
          S[tm][4 * q] = v.x; S[tm][4 * q + 1] = v.y; S[tm][4 * q + 2] = v.z; S[tm][4 * q + 3] = v.w;
        }
      }
    }
#pragma unroll
    for (int ti = 0; ti < 2; ++ti) {
      const char* up = blob0 + 57344 + (size_t)(((ti * 4 + w) * 64 + lane) * 32);
      un[ti][0] = *(const u32x4*)up;
      un[ti][1] = *(const u32x4*)(up + 16);
    }
  } else {
    u32x4 tmp[14];
#pragma unroll
    for (int p = 0; p < 14; ++p) tmp[p] = __builtin_nontemporal_load((const u32x4*)(blob0 + (size_t)(t + 256 * p) * 16));
#pragma unroll
    for (int p = 0; p < 14; ++p) *(u32x4*)(smem + (t + 256 * p) * 16) = tmp[p];
  }
  lds_barrier();
#pragma unroll 1
  for (int cj = 0; cj < nch; ++cj) {
    const char* sbuf = smem + (cj & 1) * 65536;
    if (half == 1) {
      if (cj + 1 < nch) {
        const char* blob = blob0 + (size_t)(cj + 1) * BLOB;
        char* dbuf = smem + ((cj + 1) & 1) * 65536;
        u32x4 tmp[14];
#pragma unroll
        for (int p = 0; p < 14; ++p) tmp[p] = __builtin_nontemporal_load((const u32x4*)(blob + (size_t)(t + 256 * p) * 16));
#pragma unroll
        for (int p = 0; p < 14; ++p) *(u32x4*)(dbuf + (t + 256 * p) * 16) = tmp[p];
      }
    } else {
      f32x16 vn[2];
#pragma unroll
      for (int ti = 0; ti < 2; ++ti)
#pragma unroll
        for (int e = 0; e < 4; ++e) {
          vn[ti][2 * e] = bflo(un[ti][0][e]); vn[ti][2 * e + 1] = bfhi(un[ti][0][e]);
          vn[ti][8 + 2 * e] = bflo(un[ti][1][e]); vn[ti][8 + 2 * e + 1] = bfhi(un[ti][1][e]);
        }
      const float glv = GL[cj];
      if (cj + 1 < nch) {
        const char* blob = blob0 + (size_t)(cj + 1) * BLOB;
#pragma unroll
        for (int ti = 0; ti < 2; ++ti) {
          const char* up = blob + 57344 + (size_t)(((ti * 4 + w) * 64 + lane) * 32);
          un[ti][0] = *(const u32x4*)up;
          un[ti][1] = *(const u32x4*)(up + 16);
        }
      }
      bf16x8 Sb[4][2];
#pragma unroll
      for (int tm = 0; tm < 4; ++tm) { Sb[tm][0] = pack_step(S[tm], 0); Sb[tm][1] = pack_step(S[tm], 1); }
      f32x16 o[2];
      o[0] = zero16(); o[1] = zero16();
      {
        bf16x8 fa[2][4];
#pragma unroll
        for (int s = 0; s < 2; ++s) {
          fa[0][s] = *(const bf16x8*)(sbuf + ((s) * 64 + lane) * 16);
          fa[0][2 + s] = *(const bf16x8*)(sbuf + 16384 + ((s) * 64 + lane) * 16);
        }
#pragma unroll
        for (int idx = 0; idx < 8; ++idx) {
          const int ti = idx >> 2, tk = idx & 3;
          if (idx + 1 < 8) {
            const int ti2 = (idx + 1) >> 2, tk2 = (idx + 1) & 3;
#pragma unroll
            for (int s = 0; s < 2; ++s) {
              const int fo = (((ti2 * 4 + tk2) * 2 + s) * 64 + lane) * 16;
              fa[(idx + 1) & 1][s] = *(const bf16x8*)(sbuf + fo);
              fa[(idx + 1) & 1][2 + s] = *(const bf16x8*)(sbuf + 16384 + fo);
            }
          }
          __builtin_amdgcn_sched_barrier(0);
#pragma unroll
          for (int s = 0; s < 2; ++s) {
            vn[ti] = MFMA(fa[idx & 1][s], Sb[tk][s], vn[ti]);
            o[ti] = MFMA(fa[idx & 1][2 + s], Sb[tk][s], o[ti]);
          }
          __builtin_amdgcn_sched_barrier(0);
        }
      }
      bf16x8 vb[2][2];
#pragma unroll
      for (int ti = 0; ti < 2; ++ti) { vb[ti][0] = pack_step(vn[ti], 0); vb[ti][1] = pack_step(vn[ti], 1); }
      {
        bf16x8 fq[6];
#pragma unroll
        for (int q = 0; q < 6; ++q) {
          const int ti = (q >= 2) ? 1 : 0, tj = (q >= 4) ? 1 : 0, s = q & 1;
          fq[q] = *(const bf16x8*)(sbuf + 49152 + (((ti * 2 + tj) * 2 + s) * 64 + lane) * 16);
        }
        bf16x8 fk[2][4];
#pragma unroll
        for (int q = 0; q < 4; ++q) fk[0][q] = *(const bf16x8*)(sbuf + 32768 + (q * 64 + lane) * 16);
        __builtin_amdgcn_sched_barrier(0);
#pragma unroll
        for (int q = 0; q < 6; ++q) {
          const int ti = (q >= 2) ? 1 : 0, tj = (q >= 4) ? 1 : 0, s = q & 1;
          o[ti] = MFMA(fq[q], vb[tj][s], o[ti]);
        }
#pragma unroll
        for (int tm = 0; tm < 4; ++tm) {
          if (tm + 1 < 4) {
#pragma unroll
            for (int q = 0; q < 4; ++q) fk[(tm + 1) & 1][q] = *(const bf16x8*)(sbuf + 32768 + ((((tm + 1) * 4) + q) * 64 + lane) * 16);
          }
          __builtin_amdgcn_sched_barrier(0);
#pragma unroll
          for (int g = 0; g < 16; ++g) S[tm][g] *= glv;
#pragma unroll
          for (int q = 0; q < 4; ++q) S[tm] = MFMA(fk[tm & 1][q], vb[q >> 1][q & 1], S[tm]);
          __builtin_amdgcn_sched_barrier(0);
        }
      }
      if (seg > 0) {
        const int cs = (seg - 1) * 8 + cj;
        const int corig = dir ? (63 - cs) : cs;
        int sgn = dir ? -1024 : 1024;
        asm volatile("" : "+v"(sgn));
        const int base_idx = (b * 4096 + corig * 64 + (dir ? (63 - 4 * fh) : (4 * fh))) * 1024 + h * 128 + w * 32 + fr;
#pragma unroll
        for (int ti = 0; ti < 2; ++ti)
#pragma unroll
          for (int g = 0; g < 16; ++g) {
            const int idx = base_idx + sgn * (ti * 32 + (g & 3) + 8 * (g >> 2));
            __builtin_nontemporal_store(f2bf(o[ti][g]), OB + idx);
          }
      }
    }
    lds_barrier();
  }
  if (half == 0) {
#pragma unroll
    for (int tm = 0; tm < 4; ++tm)
#pragma unroll
      for (int q = 0; q < 4; ++q) {
        float4 v = {S[tm][4 * q], S[tm][4 * q + 1], S[tm][4 * q + 2], S[tm][4 * q + 3]};
        *(float4*)(ST + tm * 1024 + lane * 16 + q * 4) = v;
      }
  }
}

DI void phase_od(const Params& P) {
  const int t = ltid();
  const u16* GATES = (const u16*)(P.ws + OFF_GATES);
  const u16* OF = (const u16*)P.out;
  const u16* OBk = (const u16*)P.out + (size_t)NLAT * 1024;
  u16* OD = (u16*)(P.ws + OFF_OD);
  const int d0 = (t & 15) * 8;
  float nw[8];
#pragma unroll
  for (int e = 0; e < 8; ++e) nw[e] = P.dn_norm_w[d0 + e];
  for (int it0 = blockIdx.x; it0 < NLAT * 8 / 32; it0 += gridDim.x * 4) {
    u32x4 a[4], bq[4], gt[4];
    size_t off[4];
#pragma unroll
    for (int u = 0; u < 4; ++u) {
      const int it = it0 + u * gridDim.x;
      const bool ok = it < NLAT * 8 / 32;
      const int pair = (ok ? it : it0) * 32 + (t >> 4);
      const size_t token = pair >> 3;
      const int hh = pair & 7;
      off[u] = token * 1024 + hh * 128 + d0;
      a[u] = __builtin_nontemporal_load((const u32x4*)(OF + off[u]));
      bq[u] = __builtin_nontemporal_load((const u32x4*)(OBk + off[u]));
      gt[u] = *(const u32x4*)(GATES + token * 3584 + 512 + hh * 128 + d0);
    }
#pragma unroll
    for (int u = 0; u < 4; ++u) {
      const int it = it0 + u * gridDim.x;
      float o[8];
      float ss = 0.f;
#pragma unroll
      for (int e = 0; e < 4; ++e) {
        o[2 * e] = bflo(a[u][e]) + bflo(bq[u][e]);
        o[2 * e + 1] = bfhi(a[u][e]) + bfhi(bq[u][e]);
        ss += o[2 * e] * o[2 * e] + o[2 * e + 1] * o[2 * e + 1];
      }
      ss = sum16(ss);
      const float r = rsqrtf(ss * (1.f / 128.f) + 1e-6f);
      u32x4 ov;
#pragma unroll
      for (int e = 0; e < 4; ++e)
        ov[e] = pk2(o[2 * e] * r * nw[2 * e] * bflo(gt[u][e]), o[2 * e + 1] * r * nw[2 * e + 1] * bfhi(gt[u][e]));
      if (it < NLAT * 8 / 32) *(u32x4*)(OD + off[u]) = ov;
    }
  }
}

DI void phase_final_ln(const Params& P) {
  const int t = ltid(), lane = t & 63, w = t >> 6;
  const float* POS = (const float*)(P.ws + OFF_POS);
  const u16* G = (const u16*)(P.ws + OFF_OD);
  const int stride = gridDim.x * 8;
  float4 lgv[4], lbv[4];
#pragma unroll
  for (int i = 0; i < 4; ++i) { lgv[i] = *(const float4*)(P.ln_g + lane * 4 + 256 * i); lbv[i] = *(const float4*)(P.ln_b + lane * 4 + 256 * i); }
  for (int row0 = blockIdx.x * 8 + w; row0 < NLAT; row0 += 4 * stride) {
    float v[4][16];
#pragma unroll
    for (int u = 0; u < 4; ++u) {
      const int row = (row0 + u * stride < NLAT) ? row0 + u * stride : row0;
      const float* xp = P.x + (size_t)row * 1024;
      const u16* gp = G + (size_t)row * 1024;
      const int n = row & 4095, pr = n >> 6, pc = n & 63;
#pragma unroll
      for (int i = 0; i < 4; ++i) {
        const int col = lane * 4 + 256 * i;
        const f32x4 a4 = __builtin_nontemporal_load((const f32x4*)(xp + col));
        const float4 a = {a4[0], a4[1], a4[2], a4[3]};
        const float4 q = *(const float4*)((col < 512) ? (POS + pr * 512 + col) : (POS + 32768 + pc * 512 + (col - 512)));
        const u32x2 g = __builtin_nontemporal_load((const u32x2*)(gp + col));
        v[u][4 * i] = (a.x + q.x) * 1.189207115002721f + bflo(g[0]);
        v[u][4 * i + 1] = (a.y + q.y) * 1.189207115002721f + bfhi(g[0]);
        v[u][4 * i + 2] = (a.z + q.z) * 1.189207115002721f + bflo(g[1]);
        v[u][4 * i + 3] = (a.w + q.w) * 1.189207115002721f + bfhi(g[1]);
      }
    }
#pragma unroll
    for (int u = 0; u < 4; ++u) {
      const int row = row0 + u * stride;
      float s = 0.f;
#pragma unroll
      for (int i = 0; i < 16; ++i) s += v[u][i];
      const float mean = wave_sum(s) * (1.f / 1024.f);
      float q = 0.f;
#pragma unroll
      for (int i = 0; i < 16; ++i) { const float d = v[u][i] - mean; q += d * d; }
      const float rstd = rsqrtf(wave_sum(q) * (1.f / 1024.f) + 1e-6f);
      if (row < NLAT) {
        float* p = P.out + (size_t)row * 1024;
#pragma unroll
        for (int i = 0; i < 4; ++i) {
          const int col = lane * 4 + 256 * i;
          const float4 g = lgv[i];
          const float4 bb = lbv[i];
          float4 o;
          o.x = (v[u][4 * i] - mean) * rstd * g.x + bb.x;
          o.y = (v[u][4 * i + 1] - mean) * rstd * g.y + bb.y;
          o.z = (v[u][4 * i + 2] - mean) * rstd * g.z + bb.z;
          o.w = (v[u][4 * i + 3] - mean) * rstd * g.w + bb.w;
          const f32x4 o4 = {o.x, o.y, o.z, o.w};
          __builtin_nontemporal_store(o4, (f32x4*)(p + col));
        }
      }
    }
  }
}

__global__ void __launch_bounds__(512, 2) fwd_megakernel(Params P0) {
  extern __shared__ __attribute__((aligned(16))) unsigned char dynsm[];
  char* smem = (char*)dynsm;
  cg::grid_group grid = cg::this_grid();
  volatile LAS unsigned* xb_st = (volatile LAS unsigned*)(dynsm + SMEM_BYTES);
  if (threadIdx.x == 0) { xb_st[0] = 0u; xb_st[1] = 0u; xb_st[2] = 0u; xb_st[3] = 0u; }
  __syncthreads();
  XcdBarrier xb = xcd_barrier_post((unsigned*)(P0.ws + OFF_BAR), xb_st);
  const Params& P = P0;
  u16* WT1 = (u16*)(P.ws + OFF_WT1);
  u16* H = (u16*)(P.ws + OFF_H);
  u16* GATES = (u16*)(P.ws + OFF_GATES);
  u16* YF = (u16*)P.out;
  for (int ph = P0.phase_lo; ph <= P0.phase_hi; ++ph) {
   for (int rep = 0; rep < ((ph == PROBE_DUP) ? 2 : 1); ++rep) {
    if (rep) xcd_barrier(xb);
    switch (ph) {
      case 0: phase_prep(P, smem, 0); break;
      case 1: phase_ln_mod(P); phase_prep(P, smem, 1); break;
      case 2: {
        EpiYT e1; e1.YT = (u16*)P.out;
        run_gemm(dynsm, WT1, H, 1024, NLAT, 1024, e1);
        EpiQKV e2; e2.QKV = (u16*)(P.ws + OFF_QKV); e2.BD = (float*)(P.ws + OFF_BD);
        run_gemm(dynsm, H, WT1 + (size_t)1024 * 1024, NROWS, 3328, 1024, e2);
      } break;
      case 3: phase_preadd(P); break;
      case 4: {
        EpiDFT e; e.MIXED = (u16*)(P.ws + OFF_MIXED);
        run_gemm(dynsm, (const u16*)P.out + (size_t)4096 * 8192, (const u16*)P.out + (size_t)4096 * 8192 + (size_t)4096 * 4096, 4096, 4096, 4096, e);
        prep_segment(P, 0, smem, xb_st);
      } break;
      case 14: {
        EpiGates e; e.GATES = GATES;
        run_gemm(dynsm, H, WT1 + (size_t)WT1_GATES_ROW * 1024, NLAT, 3584, 1024, e);
      } break;
      case 15: {
        phase_od(P);
        EpiGated e; e.OUT = (u16*)(P.ws + OFF_MG); e.ldo = 512; e.GATES = GATES; e.gcol0 = 0; e.ADD = nullptr;
        run_gemm(dynsm, (const u16*)(P.ws + OFF_MIXED), (const u16*)(P.ws + OFF_WFMIX), NLAT, 512, 512, e);
      } break;
      case 16: {
        {
          EpiGated e; e.OUT = YF; e.ldo = 1024; e.GATES = GATES; e.gcol0 = 1536; e.ADD = nullptr;
          run_gemm(dynsm, (const u16*)(P.ws + OFF_MG), (const u16*)(P.ws + OFF_WFOUT), NLAT, 1024, 512, e);
        }
        {
          EpiGated e; e.OUT = (u16*)(P.ws + OFF_MERGED); e.ldo = 1024; e.GATES = GATES; e.gcol0 = 2560; e.ADD = YF;
          run_gemm(dynsm, (const u16*)(P.ws + OFF_OD), (const u16*)(P.ws + OFF_WDN), NLAT, 1024, 1024, e);
        }
      } break;
      case 17: {
        EpiGateOut e; e.G = (u16*)(P.ws + OFF_OD); e.MOD = (const float*)(P.ws + OFF_MOD);
        run_gemm(dynsm, (const u16*)(P.ws + OFF_MERGED), (const u16*)(P.ws + OFF_WOUT), NLAT, 1024, 1024, e);
      } break;
      case 18: phase_final_ln(P); break;
      default: {
        const int seg = ph - 5;
        if (blockIdx.x < 128) scan_segment(P, seg, smem);
        if (seg < 8) {
          prep_segment(P, seg + 1, smem, xb_st);
        }
      } break;
    }
   }
    if (ph < P0.phase_hi) { if (ph >= 1000) grid.sync(); else xcd_barrier(xb); }
  }
}

extern "C" void kernel_launch(void* const* d_in, const int* in_sizes, int n_in, void* d_out, int out_size, void* d_ws,
                              size_t ws_size, hipStream_t stream) {
  (void)in_sizes; (void)n_in; (void)out_size;
  if (ws_size < WS_NEEDED) { fprintf(stderr, "workspace too small: %zu < %zu\n", ws_size, (size_t)WS_NEEDED); return; }
  static int grid_blocks = 0;
  if (!grid_blocks) {
    int dev = 0, cus = 0, per_cu = 0;
    (void)hipGetDevice(&dev);
    (void)hipDeviceGetAttribute(&cus, hipDeviceAttributeMultiprocessorCount, dev);
    if (hipFuncSetAttribute((const void*)fwd_megakernel, hipFuncAttributeMaxDynamicSharedMemorySize, SMEM_BYTES + 16) != hipSuccess)
      fprintf(stderr, "hipFuncSetAttribute(dynamic LDS %d) failed\n", SMEM_BYTES);
    (void)hipOccupancyMaxActiveBlocksPerMultiprocessor(&per_cu, fwd_megakernel, 512, SMEM_BYTES + 16);
    (void)hipGetLastError();
    grid_blocks = cus;
  }
  Params p{};
  p.x = (const float*)d_in[0]; p.c = (const float*)d_in[1]; p.ctx = (const float*)d_in[2]; p.c_ctx = (const float*)d_in[3];
  p.w_mod = (const float*)d_in[4]; p.b_mod = (const float*)d_in[5]; p.w_in = (const float*)d_in[6];
  p.conv_w = (const float*)d_in[7]; p.a_log = (const float*)d_in[8]; p.dt_bias = (const float*)d_in[9];
  p.dn_norm_w = (const float*)d_in[10]; p.w_dn_out = (const float*)d_in[11]; p.w_fmix = (const float*)d_in[12];
  p.w_f_out = (const float*)d_in[13]; p.w_out = (const float*)d_in[14]; p.ln_g = (const float*)d_in[15];
  p.ln_b = (const float*)d_in[16];
  p.out = (float*)d_out;
  p.ws = (char*)d_ws;
  (void)hipMemsetAsync((char*)d_ws + OFF_BAR, 0, 40960, stream);
#if MK_MULTI
  for (int ph = 0; ph < NPHASE; ++ph) {
    p.phase_lo = ph; p.phase_hi = ph;
    hipLaunchKernelGGL(fwd_megakernel, dim3(grid_blocks), dim3(512), SMEM_BYTES + 16, stream, p);
  }
#else
  p.phase_lo = 0; p.phase_hi = NPHASE - 1;
  void* args[] = {&p};
  hipError_t e = hipLaunchCooperativeKernel((void*)fwd_megakernel, dim3(grid_blocks), dim3(512), args, SMEM_BYTES + 16, stream);
  if (e != hipSuccess) fprintf(stderr, "cooperative launch failed: %s (grid %d)\n", hipGetErrorString(e), grid_blocks);
#endif
}
```

```cpp
#include <hip/hip_runtime.h>
#include <hip/hip_cooperative_groups.h>
#include <cstdio>
namespace cg = cooperative_groups;

#ifndef MK_MULTI
#define MK_MULTI 0
#endif
#ifndef PROBE_DUP
#define PROBE_DUP -1
#endif
#ifndef PROBE_DUP_PREP
#define PROBE_DUP_PREP 0
#endif

typedef unsigned short u16;
using bf16x8 = __attribute__((ext_vector_type(8))) short;
using f32x16 = __attribute__((ext_vector_type(16))) float;
using f32x4 = __attribute__((ext_vector_type(4))) float;
using u32x4 = __attribute__((ext_vector_type(4))) unsigned;
using u32x2 = __attribute__((ext_vector_type(2))) unsigned;
typedef __bf16 bf2_t __attribute__((ext_vector_type(2)));
typedef float f2_t __attribute__((ext_vector_type(2)));
#define DI __device__ __forceinline__
#define MFMA(a, b, c) __builtin_amdgcn_mfma_f32_32x32x16_bf16((a), (b), (c), 0, 0, 0)

constexpr int NLAT = 32768;
constexpr int NROWS = 34816;
constexpr size_t MiB = 1u << 20;
constexpr size_t OFF_WT1 = 0;
constexpr size_t OFF_WFMIX = 16 * MiB;
constexpr size_t OFF_WFOUT = 17 * MiB;
constexpr size_t OFF_WDN = 18 * MiB;
constexpr size_t OFF_WOUT = 20 * MiB;
constexpr size_t OFF_POS = 22 * MiB;
constexpr size_t OFF_MOD = 23 * MiB;
constexpr size_t OFF_GL = 23 * MiB + 512 * 1024;
constexpr size_t OFF_BAR = 23 * MiB + 768 * 1024;
constexpr size_t OFF_STATE = 24 * MiB;
constexpr size_t OFF_BD = 32 * MiB;
constexpr size_t OFF_H = 37 * MiB;
constexpr size_t OFF_MIXED = 105 * MiB;
constexpr size_t OFF_QKV = 137 * MiB;
constexpr size_t OFF_OPBUF = 341 * MiB;
constexpr size_t OPBUF_SLOT = 72 * MiB;
constexpr size_t OFF_GATES = 137 * MiB;
constexpr size_t OFF_OD = 361 * MiB;
constexpr size_t OFF_MG = 425 * MiB;
constexpr size_t OFF_MERGED = 37 * MiB;
constexpr size_t WS_NEEDED = 485 * MiB;
constexpr int BLOB = 73728;
constexpr int HALF_SMEM = 73728;
constexpr int SMEM_BYTES = 2 * HALF_SMEM;
constexpr int NPHASE = 19;
constexpr int WT1_GATES_ROW = 4352;

struct Params {
  const float *x, *c, *ctx, *c_ctx, *w_mod, *b_mod, *w_in, *conv_w, *a_log, *dt_bias, *dn_norm_w, *w_dn_out, *w_fmix,
      *w_f_out, *w_out, *ln_g, *ln_b;
  float* out;
  char* ws;
  int phase_lo, phase_hi;
};

DI unsigned pk2(float a, float b) {
  f2_t v = {a, b};
  bf2_t r = __builtin_convertvector(v, bf2_t);
  return __builtin_bit_cast(unsigned, r);
}
DI u16 f2bf(float a) { return (u16)(pk2(a, 0.f) & 0xffffu); }
DI float bf2f(u16 v) { return __uint_as_float(((unsigned)v) << 16); }
DI float bflo(unsigned v) { return __uint_as_float(v << 16); }
DI float bfhi(unsigned v) { return __uint_as_float(v & 0xffff0000u); }
DI float silu_f(float x) { return x * __builtin_amdgcn_rcpf(1.f + __expf(-x)); }
DI float sigm_f(float x) { return __builtin_amdgcn_rcpf(1.f + __expf(-x)); }
DI int ltid() { int t = threadIdx.x; asm volatile("" : "+v"(t)); return t; }
DI int crow(int reg, int h) { return (reg & 3) + 8 * (reg >> 2) + 4 * h; }
DI bf16x8 pack_step(const f32x16& x, int s) {
  u32x4 p;
  p[0] = pk2(x[8 * s + 0], x[8 * s + 1]);
  p[1] = pk2(x[8 * s + 2], x[8 * s + 3]);
  p[2] = pk2(x[8 * s + 4], x[8 * s + 5]);
  p[3] = pk2(x[8 * s + 6], x[8 * s + 7]);
  return __builtin_bit_cast(bf16x8, p);
}
DI f32x16 zero16() {
  f32x16 z;
#pragma unroll
  for (int i = 0; i < 16; ++i) z[i] = 0.f;
  return z;
}
#define DPP_ADD(v, CTRL) ((v) + __builtin_bit_cast(float, __builtin_amdgcn_update_dpp(0, __builtin_bit_cast(int, (v)), (CTRL), 0xf, 0xf, true)))
DI float sum16(float v) {
  v = DPP_ADD(v, 0xB1);
  v = DPP_ADD(v, 0x4E);
  v = DPP_ADD(v, 0x141);
  v = DPP_ADD(v, 0x140);
  return v;
}
DI float wave_sum(float v) {
  v = sum16(v);
  v += __shfl_xor(v, 16);
  v += __shfl_xor(v, 32);
  return v;
}

namespace pg8 {
#define PG8_LAS __attribute__((address_space(3)))
typedef unsigned short bf16_t;
typedef short bf16x8 __attribute__((ext_vector_type(8)));
typedef float f32x4 __attribute__((ext_vector_type(4)));
typedef unsigned u32x4 __attribute__((ext_vector_type(4)));
constexpr int BM = 256, BK = 64, HALF = 128, HTB = HALF * BK * 2  , STAGE_BYTES = 8 * HTB, NXCD = 8, WGM = 8;

__host__ __device__ __forceinline__ int lds_byte(int r, int c) { const int st = (r >> 4) * 2 + (c >> 5), rr = r & 15, cc = c & 31, ob = rr * 64 + cc * 2; return st * 1024 + (ob ^ (((ob >> 9) & 1) << 5)); }
__host__ __device__ __forceinline__ void stage_rc(int b, int& R, int& C) { const int st = b / 1024, sb = b % 1024, swz = sb ^ (((sb >> 9) & 1) << 5); R = (st >> 1) * 16 + swz / 64; C = (st & 1) * 32 + (swz % 64) / 2; }
__host__ __device__ __forceinline__ int perm32(int rho) { const int n = rho >> 4, i = rho & 15; return 8 * (i >> 2) + 4 * n + (i & 3); }

struct Unit { int pm, pn; };
struct Gemm { const bf16_t* A; const bf16_t* Bt; int M, N, K; };

struct StaticOrder {
    int nM, nN, nwg, G, c;
    __host__ __device__ void init(int M, int N, int G_, int c_) { nM = M / BM; nN = N / BM; nwg = nM * nN; G = G_; c = c_; }
    __host__ __device__ bool next(int i, Unit& u) const {
        const long L = (long)i * G + c; if (L >= nwg) return false;
        int wgid = (int)L; { const int q = nwg / NXCD, r = nwg % NXCD, xcd = wgid % NXCD, off = wgid / NXCD; wgid = (xcd < r ? xcd * (q + 1) : r * (q + 1) + (xcd - r) * q) + off; }
        const int nig = WGM * nN, gid = wgid / nig, fm = gid * WGM, gsz = (nM - fm) < WGM ? (nM - fm) : WGM;
        u.pm = fm + ((wgid % nig) % gsz); u.pn = (wgid % nig) / gsz; return true;
    }
    __device__ __forceinline__ void a_ready(const Unit&) const {}
    __device__ __forceinline__ void done(const Unit&) const {}
};
__device__ __forceinline__ unsigned cvt_pk_bf16(float lo, float hi) { unsigned r; asm volatile("v_cvt_pk_bf16_f32 %0, %1, %2" : "=v"(r) : "v"(lo), "v"(hi)); return r; }
typedef float f32x2 __attribute__((ext_vector_type(2)));
template <class Epi, class Sched>
__device__ __forceinline__ void gemm_phase(PG8_LAS unsigned char* lds, const Gemm g, const Sched& S, const Epi& E) {
    const int tid = ltid(), wid = __builtin_amdgcn_readfirstlane(tid >> 6), lane = tid & 63, wr = wid >> 2, wc = wid & 3, fr = lane & 15, fq = lane >> 4;
    const int K = g.K, nt = K / BK;
    unsigned voffA[2], voffB[2];
#pragma unroll
    for (int i = 0; i < 2; ++i) { int R, C; stage_rc(tid * 16 + i * 8192, R, C); const int Rb = Epi::PERM ? ((R & ~31) + perm32(R & 31)) : R;
        voffA[i] = (unsigned)(R * K + C) * 2u; voffB[i] = (unsigned)(Rb * K + C) * 2u; }
    const size_t kstep = (size_t)(BK * 2);
    const size_t hstep = (size_t)HALF * K * 2;
    const size_t tstep = 2 * hstep;
    const unsigned ldsw = (unsigned)wid * 1024u;
    const int aoff = lds_byte(wr * 64 + fr, fq * 8), boff = lds_byte(wc * 32 + fr, fq * 8);
#define PG8_SA(b, h) (((b) * 2 + (h)) * HTB)
#define PG8_SB(b, h) ((4 + (b) * 2 + (h)) * HTB)
#define PG8_STAGE(bufoff, gbase, voff) do { _Pragma("unroll") for (int _i = 0; _i < 2; ++_i) \
        __builtin_amdgcn_global_load_lds((const unsigned*)((const char*)(gbase) + (voff)[_i]), (PG8_LAS unsigned*)(lds + (bufoff) + ldsw + _i * 8192), 16, 0, 0); } while (0)
#define PG8_LDA(dst, b, h) do { _Pragma("unroll") for (int m = 0; m < 4; ++m) _Pragma("unroll") for (int k = 0; k < 2; ++k) dst[m][k] = *(const PG8_LAS bf16x8*)(lds + PG8_SA(b, h) + aoff + m * 2048 + k * 1024); } while (0)
#define PG8_LDB(dst, b, h) do { _Pragma("unroll") for (int n = 0; n < 2; ++n) _Pragma("unroll") for (int k = 0; k < 2; ++k) dst[n][k] = *(const PG8_LAS bf16x8*)(lds + PG8_SB(b, h) + boff + n * 2048 + k * 1024); } while (0)
#define PG8_MMA(ai, bj, At, Bt) do { __builtin_amdgcn_s_setprio(1); _Pragma("unroll") for (int m = 0; m < 4; ++m) _Pragma("unroll") for (int n = 0; n < 2; ++n) _Pragma("unroll") for (int k = 0; k < 2; ++k) \
        acc[ai][bj][m][n] = __builtin_amdgcn_mfma_f32_16x16x32_bf16(Bt[n][k], At[m][k], acc[ai][bj][m][n], 0, 0, 0); __builtin_amdgcn_s_setprio(0); } while (0)
#define PG8_WAIT_V(n) asm volatile("s_waitcnt vmcnt(" #n ")" ::: "memory")
#define PG8_WAIT_L(n) asm volatile("s_waitcnt lgkmcnt(" #n ")" ::: "memory")
#define PG8_BAR __builtin_amdgcn_s_barrier()
#define PG8_SCHED __builtin_amdgcn_sched_barrier(0)
    Unit cur, nxt; int ui = 0;
    if (!S.next(0, cur)) return;
    f32x4 acc[2][2][4][2];
#pragma unroll
    for (int a = 0; a < 2; ++a)
#pragma unroll
        for (int b = 0; b < 2; ++b)
#pragma unroll
            for (int m = 0; m < 4; ++m)
#pragma unroll
                for (int n = 0; n < 2; ++n) acc[a][b][m][n] = (f32x4){0.f, 0.f, 0.f, 0.f};
    bf16x8 At[4][2], B0[2][2], B1[2][2];
    const char* cA = (const char*)g.A + (size_t)cur.pm * tstep; const char* cB = (const char*)g.Bt + (size_t)cur.pn * tstep;
    S.a_ready(cur);
    PG8_STAGE(PG8_SB(0, 0), cB, voffB); PG8_STAGE(PG8_SA(0, 0), cA, voffA); PG8_STAGE(PG8_SB(0, 1), cB + hstep, voffB); PG8_STAGE(PG8_SA(0, 1), cA + hstep, voffA);
    if (wr == 1) PG8_BAR;
    PG8_WAIT_V(4); PG8_BAR;
    PG8_STAGE(PG8_SB(1, 0), cB + kstep, voffB); PG8_STAGE(PG8_SA(1, 0), cA + kstep, voffA); PG8_STAGE(PG8_SB(1, 1), cB + hstep + kstep, voffB);
    PG8_WAIT_V(6); PG8_BAR;
    for (;;) {
        const bool has_next = S.next(ui + 1, nxt);
        const char* nA = has_next ? (const char*)g.A + (size_t)nxt.pm * tstep : cA; const char* nB = has_next ? (const char*)g.Bt + (size_t)nxt.pn * tstep : cB;
        for (int t = 0; t < nt; t += 2) {
            const bool last = (t == nt - 2);
            const char* a1 = cA + (size_t)(t + 1) * kstep;
            const char* a2 = last ? nA : cA + (size_t)(t + 2) * kstep; const char* b2 = last ? nB : cB + (size_t)(t + 2) * kstep;
            const char* a3 = a2 + kstep; const char* b3 = b2 + kstep;
            if (last && has_next) S.a_ready(nxt);
            PG8_LDB(B0, 0, 0); PG8_SCHED; PG8_LDA(At, 0, 0); PG8_STAGE(PG8_SA(1, 1), a1 + hstep, voffA);
            PG8_WAIT_L(8); PG8_BAR; PG8_WAIT_L(0); PG8_MMA(0, 0, At, B0); PG8_BAR; PG8_SCHED;
            PG8_LDB(B1, 0, 1); PG8_STAGE(PG8_SB(0, 0), b2, voffB);
            PG8_BAR; PG8_WAIT_L(0); PG8_MMA(0, 1, At, B1); PG8_BAR;
            PG8_LDA(At, 0, 1); PG8_STAGE(PG8_SA(0, 0), a2, voffA);
            PG8_BAR; PG8_WAIT_L(0); PG8_MMA(1, 0, At, B0); PG8_BAR; PG8_SCHED;
            PG8_STAGE(PG8_SB(0, 1), b2 + hstep, voffB);
            PG8_WAIT_V(6); PG8_BAR; PG8_MMA(1, 1, At, B1); PG8_BAR;
            PG8_LDB(B0, 1, 0); PG8_SCHED; PG8_LDA(At, 1, 0); PG8_STAGE(PG8_SA(0, 1), a2 + hstep, voffA);
            PG8_WAIT_L(8); PG8_BAR; PG8_WAIT_L(0); PG8_MMA(0, 0, At, B0); PG8_BAR; PG8_SCHED;
            PG8_LDB(B1, 1, 1); PG8_STAGE(PG8_SB(1, 0), b3, voffB);
            PG8_BAR; PG8_WAIT_L(0); PG8_MMA(0, 1, At, B1); PG8_BAR;
            PG8_LDA(At, 1, 1); PG8_STAGE(PG8_SA(1, 0), a3, voffA);
            PG8_BAR; PG8_WAIT_L(0); PG8_MMA(1, 0, At, B0); PG8_BAR; PG8_SCHED;
            PG8_STAGE(PG8_SB(1, 1), b3 + hstep, voffB);
            PG8_WAIT_V(6); PG8_BAR; PG8_MMA(1, 1, At, B1); PG8_BAR;
        }
        if constexpr (!Epi::AFTER_DRAIN) { E(acc, cur, wr, wc, fr, fq); S.done(cur); }
        if (!has_next) break;
#pragma unroll
        for (int a = 0; a < 2; ++a)
#pragma unroll
            for (int b = 0; b < 2; ++b)
#pragma unroll
                for (int m = 0; m < 4; ++m)
#pragma unroll
                    for (int n = 0; n < 2; ++n) acc[a][b][m][n] = (f32x4){0.f, 0.f, 0.f, 0.f};
        cur = nxt; cA = nA; cB = nB; ++ui;
    }
    PG8_WAIT_V(0);
    if (wr == 0) PG8_BAR;
    PG8_BAR;
    if constexpr (Epi::AFTER_DRAIN) { E.fused(acc, cur, wr, wc, fr, fq, lds, wid, lane); S.done(cur); }
#undef PG8_SA
#undef PG8_SB
#undef PG8_STAGE
#undef PG8_LDA
#undef PG8_LDB
#undef PG8_MMA
#undef PG8_WAIT_V
#undef PG8_WAIT_L
#undef PG8_BAR
#undef PG8_SCHED
}
}

#include <cstdint>
#define XB_TMO      128
#define XB_XCNT(j)  (256  + 64 * (j))
#define XB_XSUB(j)  (1280 + 64 * (j))
#define XB_XGEN(j)  (2304 + 64 * (j))
#define XB_TOP      3328
#define XB_TOPGEN   3392
#define XCD_BAR_WORDS 3456
#define XB_SPIN_CAP (1u << 18)
#define LAS __attribute__((address_space(3)))

__device__ __forceinline__ unsigned xb_ld(unsigned* p)              { return __hip_atomic_load(p, __ATOMIC_RELAXED, __HIP_MEMORY_SCOPE_AGENT); }
__device__ __forceinline__ unsigned xb_add(unsigned* p, unsigned v) { return __hip_atomic_fetch_add(p, v, __ATOMIC_RELAXED, __HIP_MEMORY_SCOPE_AGENT); }
__device__ __forceinline__ unsigned xb_xcc_id() { return (unsigned)__builtin_amdgcn_s_getreg((3 << 11) | 20) & 0xFu; }
#define XB_SPIN(cond, bar) do { unsigned _sp = 0; while (cond) { __builtin_amdgcn_s_sleep(1); \
    if ((++_sp & 255u) == 0u) { if (xb_ld(&(bar)[XB_TMO])) break; if (_sp > XB_SPIN_CAP) { atomicAdd(&(bar)[XB_TMO], 1u); break; } } } } while (0)

struct XcdBarrier {
    unsigned* bar; unsigned x;
    volatile LAS unsigned* st;
};

__device__ __forceinline__ XcdBarrier xcd_barrier_post(unsigned* bar, volatile LAS unsigned* st) {
    XcdBarrier b; b.bar = bar; b.x = xb_xcc_id(); b.st = st;
    if (threadIdx.x == 0) (void)xb_add(&bar[XB_XCNT(b.x)], 1u);
    return b;
}
__device__ __forceinline__ void xcd_barrier_complete(unsigned* bar, unsigned x, unsigned& nloc, unsigned& nx) {
    const unsigned G = gridDim.x * gridDim.y * gridDim.z;
    unsigned sum, cnt, mine, sp = 0u;
    for (;;) {
        sum = 0u; cnt = 0u; mine = 0u;
#pragma unroll
        for (unsigned j = 0; j < 16; ++j) { const unsigned c = xb_ld(&bar[XB_XCNT(j)]); sum += c; cnt += (c > 0u) ? 1u : 0u; mine = (j == x) ? c : mine; }
        if (sum == G) break;
        __builtin_amdgcn_s_sleep(1);
        if ((++sp & 255u) == 0u) { if (xb_ld(&bar[XB_TMO])) break; if (sp > XB_SPIN_CAP) { atomicAdd(&bar[XB_TMO], 1u); break; } }
    }
    nloc = mine > 0u ? mine : 1u; nx = cnt > 0u ? cnt : 1u;
}

__device__ __forceinline__ void xcd_barrier(const XcdBarrier& b) {
    asm volatile("s_waitcnt vmcnt(0)" ::: "memory");
    __syncthreads();
    if (threadIdx.x == 0) {
        unsigned* bar = b.bar;
        __builtin_amdgcn_s_waitcnt(0);
        unsigned nloc = b.st[0], nx = b.st[1];
        if (nloc == 0u) { xcd_barrier_complete(bar, b.x, nloc, nx); b.st[0] = nloc; b.st[1] = nx; }
        const unsigned old = xb_add(&bar[XB_XSUB(b.x)], 1u);
        const unsigned gen = old / nloc;
        if (old + 1u == (gen + 1u) * nloc) {
            __builtin_amdgcn_fence(__ATOMIC_RELEASE, "agent");
            asm volatile("s_waitcnt vmcnt(0)" ::: "memory");
            const unsigned og = xb_add(&bar[XB_TOP], 1u);
            const unsigned tg = og / nx;
            if (og + 1u == (tg + 1u) * nx) xb_add(&bar[XB_TOPGEN], 1u);
            else XB_SPIN(xb_ld(&bar[XB_TOPGEN]) == tg, bar);
            __builtin_amdgcn_fence(__ATOMIC_ACQUIRE, "agent");
            xb_add(&bar[XB_XGEN(b.x)], 1u);
            asm volatile("s_waitcnt vmcnt(0)" ::: "memory");
        } else {
            XB_SPIN(xb_ld(&bar[XB_XGEN(b.x)]) == gen, bar);
            __builtin_amdgcn_fence(__ATOMIC_ACQUIRE, "agent");
            asm volatile("s_waitcnt vmcnt(0)" ::: "memory");
        }
    }
    __syncthreads();
}

typedef pg8::f32x4 a4_t;
DI u32x4 pack8(const a4_t& v0, const a4_t& v1) {
  u32x4 w = {pk2(v0[0], v0[1]), pk2(v0[2], v0[3]), pk2(v1[0], v1[1]), pk2(v1[2], v1[3])};
  return w;
}
DI void unpack8(const u32x4& g, a4_t& g0, a4_t& g1) {
  g0[0] = bflo(g[0]); g0[1] = bfhi(g[0]); g0[2] = bflo(g[1]); g0[3] = bfhi(g[1]);
  g1[0] = bflo(g[2]); g1[1] = bfhi(g[2]); g1[2] = bflo(g[3]); g1[3] = bfhi(g[3]);
}

struct EpiYT {
  static constexpr bool PERM = true, AFTER_DRAIN = false;
  u16* YT;
  DI void operator()(const a4_t (&acc)[2][2][4][2], const pg8::Unit& u, int wr, int wc, int fr, int fq) const {
    const int row0 = u.pm * 256 + wr * 64 + fr;
    const int b = u.pn >> 4;
    const int n0 = (u.pn & 15) * 256 + wc * 32 + 8 * fq;
#pragma unroll
    for (int ai = 0; ai < 2; ++ai)
#pragma unroll
      for (int m = 0; m < 4; ++m) {
        const int row = row0 + ai * 128 + m * 16;
        u16* rowp = YT + ((size_t)(b * 512 + (row & 511))) * 8192 + (row >> 9) * 4096 + n0;
#pragma unroll
        for (int bj = 0; bj < 2; ++bj) *(u32x4*)(rowp + bj * 128) = pack8(acc[ai][bj][m][0], acc[ai][bj][m][1]);
      }
  }
};

struct EpiQKV {
  static constexpr bool PERM = true, AFTER_DRAIN = false;
  u16* QKV; float* BD;
  DI void operator()(const a4_t (&acc)[2][2][4][2], const pg8::Unit& u, int wr, int wc, int fr, int fq) const {
    const int row0 = u.pm * 256 + wr * 64 + fr;
    if (u.pn < 12) {
      const int col0 = u.pn * 256 + wc * 32 + 8 * fq;
#pragma unroll
      for (int ai = 0; ai < 2; ++ai)
#pragma unroll
        for (int m = 0; m < 4; ++m) {
          u16* rowp = QKV + (size_t)(row0 + ai * 128 + m * 16) * 3072 + col0;
#pragma unroll
          for (int bj = 0; bj < 2; ++bj) *(u32x4*)(rowp + bj * 128) = pack8(acc[ai][bj][m][0], acc[ai][bj][m][1]);
        }
    } else if (wc == 0) {
#pragma unroll
      for (int ai = 0; ai < 2; ++ai)
#pragma unroll
        for (int m = 0; m < 4; ++m) {
          float* rowp = BD + (size_t)(row0 + ai * 128 + m * 16) * 32 + 8 * fq;
          *(a4_t*)(rowp) = acc[ai][0][m][0];
          *(a4_t*)(rowp + 4) = acc[ai][0][m][1];
        }
    }
  }
};

struct EpiDFT {
  static constexpr bool PERM = true, AFTER_DRAIN = false;
  u16* MIXED;
  DI void operator()(const a4_t (&acc)[2][2][4][2], const pg8::Unit& u, int wr, int wc, int fr, int fq) const {
    const int row0 = u.pm * 256 + wr * 64 + fr;
    const int b = u.pn >> 1;
    const int col0 = (u.pn & 1) * 256 + wc * 32 + 8 * fq;
    const float sc = 0.0013810679320049757f;
#pragma unroll
    for (int ai = 0; ai < 2; ++ai)
#pragma unroll
      for (int m = 0; m < 4; ++m) {
        u16* rowp = MIXED + ((size_t)(b * 4096 + row0 + ai * 128 + m * 16)) * 512 + col0;
#pragma unroll
        for (int bj = 0; bj < 2; ++bj) *(u32x4*)(rowp + bj * 128) = pack8(acc[ai][bj][m][0] * sc, acc[ai][bj][m][1] * sc);
      }
  }
};

struct EpiGates {
  static constexpr bool PERM = true, AFTER_DRAIN = false;
  u16* GATES;
  DI void operator()(const a4_t (&acc)[2][2][4][2], const pg8::Unit& u, int wr, int wc, int fr, int fq) const {
    const int row0 = u.pm * 256 + wr * 64 + fr;
    const int col0 = u.pn * 256 + wc * 32 + 8 * fq;
    const bool is_silu = u.pn < 6;
#pragma unroll
    for (int ai = 0; ai < 2; ++ai)
#pragma unroll
      for (int m = 0; m < 4; ++m) {
        u16* rowp = GATES + (size_t)(row0 + ai * 128 + m * 16) * 3584 + col0;
#pragma unroll
        for (int bj = 0; bj < 2; ++bj) {
          a4_t v0 = acc[ai][bj][m][0], v1 = acc[ai][bj][m][1];
#pragma unroll
          for (int j = 0; j < 4; ++j) {
            const float s0 = sigm_f(v0[j]), s1 = sigm_f(v1[j]);
            v0[j] = is_silu ? v0[j] * s0 : s0;
            v1[j] = is_silu ? v1[j] * s1 : s1;
          }
          *(u32x4*)(rowp + bj * 128) = pack8(v0, v1);
        }
      }
  }
};

struct EpiGated {
  static constexpr bool PERM = true, AFTER_DRAIN = false;
  u16* OUT; int ldo; const u16* GATES; int gcol0; const u16* ADD;
  DI void operator()(const a4_t (&acc)[2][2][4][2], const pg8::Unit& u, int wr, int wc, int fr, int fq) const {
    const int row0 = u.pm * 256 + wr * 64 + fr;
    const int col0 = u.pn * 256 + wc * 32 + 8 * fq;
#pragma unroll
    for (int ai = 0; ai < 2; ++ai) {
      u32x4 g[4][2], ad[4][2];
#pragma unroll
      for (int m = 0; m < 4; ++m)
#pragma unroll
        for (int bj = 0; bj < 2; ++bj) {
          const size_t row = (size_t)(row0 + ai * 128 + m * 16);
          const int col = col0 + bj * 128;
          g[m][bj] = *(const u32x4*)(GATES + row * 3584 + gcol0 + col);
          if (ADD) ad[m][bj] = *(const u32x4*)(ADD + row * ldo + col);
        }
      __builtin_amdgcn_sched_barrier(0);
#pragma unroll
      for (int m = 0; m < 4; ++m)
#pragma unroll
        for (int bj = 0; bj < 2; ++bj) {
          const size_t row = (size_t)(row0 + ai * 128 + m * 16);
          const int col = col0 + bj * 128;
          a4_t g0, g1;
          unpack8(g[m][bj], g0, g1);
          a4_t v0 = acc[ai][bj][m][0] * g0, v1 = acc[ai][bj][m][1] * g1;
          if (ADD) {
            a4_t d0, d1;
            unpack8(ad[m][bj], d0, d1);
            v0 += d0; v1 += d1;
          }
          *(u32x4*)(OUT + row * ldo + col) = pack8(v0, v1);
        }
      asm volatile("" ::: "memory");
    }
  }
};

struct EpiOut {
  static constexpr bool PERM = false, AFTER_DRAIN = false;
  float* OUT; const float* X; const float* POS; const float* MOD;
  DI void operator()(const a4_t (&acc)[2][2][4][2], const pg8::Unit& u, int wr, int wc, int fr, int fq) const {
    const int row0 = u.pm * 256 + wr * 64 + fr;
    const int col0 = u.pn * 256 + wc * 32 + 4 * fq;
    const int b = u.pm >> 4;
    a4_t gv[2][2];
#pragma unroll
    for (int bj = 0; bj < 2; ++bj)
#pragma unroll
      for (int n = 0; n < 2; ++n) gv[bj][n] = *(const a4_t*)(MOD + b * 3072 + 2048 + col0 + bj * 128 + n * 16);
#pragma unroll
    for (int ai = 0; ai < 2; ++ai)
#pragma unroll
      for (int m = 0; m < 4; ++m) {
        const int row = row0 + ai * 128 + m * 16;
        const int nn = row & 4095, pr = nn >> 6, pc = nn & 63;
        const float* prow = (u.pn < 2) ? (POS + pr * 512 + col0) : (POS + 32768 + pc * 512 + (col0 - 512));
        const size_t off = (size_t)row * 1024 + col0;
#pragma unroll
        for (int bj = 0; bj < 2; ++bj)
#pragma unroll
          for (int n = 0; n < 2; ++n) {
            const a4_t xv = *(const a4_t*)(X + off + bj * 128 + n * 16);
            const a4_t pe = *(const a4_t*)(prow + bj * 128 + n * 16);
            *(a4_t*)(OUT + off + bj * 128 + n * 16) = (xv + pe) * 1.189207115002721f + gv[bj][n] * acc[ai][bj][m][n];
          }
        asm volatile("" ::: "memory");
      }
  }
};

struct EpiGateOut {
  static constexpr bool PERM = true, AFTER_DRAIN = false;
  u16* G; const float* MOD;
  DI void operator()(const a4_t (&acc)[2][2][4][2], const pg8::Unit& u, int wr, int wc, int fr, int fq) const {
    const int row0 = u.pm * 256 + wr * 64 + fr;
    const int col0 = u.pn * 256 + wc * 32 + 8 * fq;
    const int b = u.pm >> 4;
    a4_t gv[2][2];
#pragma unroll
    for (int bj = 0; bj < 2; ++bj)
#pragma unroll
      for (int n = 0; n < 2; ++n) gv[bj][n] = *(const a4_t*)(MOD + b * 3072 + 2048 + col0 + bj * 128 + 4 * n);
#pragma unroll
    for (int ai = 0; ai < 2; ++ai)
#pragma unroll
      for (int m = 0; m < 4; ++m) {
        u16* rowp = G + (size_t)(row0 + ai * 128 + m * 16) * 1024 + col0;
#pragma unroll
        for (int bj = 0; bj < 2; ++bj) *(u32x4*)(rowp + bj * 128) = pack8(acc[ai][bj][m][0] * gv[bj][0], acc[ai][bj][m][1] * gv[bj][1]);
      }
  }
};

template <class Epi>
DI void run_gemm(unsigned char* smem, const u16* A, const u16* Bt, int M, int N, int K, const Epi& E) {
  pg8::Gemm g;
  g.A = A; g.Bt = Bt; g.M = M; g.N = N; g.K = K;
  pg8::StaticOrder S;
  S.init(M, N, (int)gridDim.x, (int)blockIdx.x);
  pg8::gemm_phase<Epi, pg8::StaticOrder>((PG8_LAS unsigned char*)smem, g, S, E);
  __syncthreads();
}

DI void transpose_task(const float* __restrict__ src, int ld, int col0, int k0, u16* dst, int ldd, char* smem, int t) {
  float* ts = (float*)smem;
  {
    const int c = t & 31, kr = t >> 5;
    float rv[8];
#pragma unroll
    for (int p = 0; p < 8; ++p) rv[p] = (col0 >= 0) ? src[(size_t)(k0 + kr + 8 * p) * ld + col0 + c] : 0.f;
#pragma unroll
    for (int p = 0; p < 8; ++p) ts[(kr + 8 * p) * 33 + c] = rv[p];
  }
  __syncthreads();
  {
    const int wr = t >> 3, kc = t & 7;
    u32x4 v;
#pragma unroll
    for (int e = 0; e < 4; ++e) v[e] = pk2(ts[(kc * 8 + 2 * e) * 33 + wr], ts[(kc * 8 + 2 * e + 1) * 33 + wr]);
    *(u32x4*)(dst + (size_t)wr * ldd + k0 + kc * 8) = v;
  }
  __syncthreads();
}

DI void transpose_task4(const float* __restrict__ src, int ld, int col0, int k0, u16* dst, int ldd, char* smem, int t) {
  float* ts = (float*)smem;
  {
    const int c = t & 31, kr = t >> 5;
#pragma unroll 1
    for (int pb = 0; pb < 32; pb += 16) {
      float rv[16];
#pragma unroll
      for (int p = 0; p < 16; ++p) rv[p] = (col0 >= 0) ? src[(size_t)(k0 + kr + 8 * (pb + p)) * ld + col0 + c] : 0.f;
#pragma unroll
      for (int p = 0; p < 16; ++p) ts[(kr + 8 * (pb + p)) * 33 + c] = rv[p];
    }
  }
  __syncthreads();
  {
    const int wr = t >> 3, kc = t & 7;
#pragma unroll
    for (int q = 0; q < 4; ++q) {
      u32x4 v;
#pragma unroll
      for (int e = 0; e < 4; ++e) v[e] = pk2(ts[(q * 64 + kc * 8 + 2 * e) * 33 + wr], ts[(q * 64 + kc * 8 + 2 * e + 1) * 33 + wr]);
      *(u32x4*)(dst + (size_t)wr * ldd + k0 + q * 64 + kc * 8) = v;
    }
  }
  __syncthreads();
}

DI int wt1_srccol(int row) {
  if (row < 4096) return row;
  if (row < 4128) return 5120 + (row - 4096);
  if (row < 4352) return -1;
  if (row < 4864) return 512 + (row - 4352);
  if (row < 5888) return 4096 + (row - 4864);
  return 5152 + (row - 5888);
}

DI void phase_prep(const Params& P, char* smem_all, int first_kind) {
  const int tt = ltid();
  const int half = tt >> 8, t = tt & 255;
  char* smem = smem_all + half * HALF_SMEM;
  u16* WT1 = (u16*)(P.ws + OFF_WT1);
  constexpr int T_IN = 216 * 4;
  constexpr int T_FOUT = 32 * 2, T_DN = 32 * 4, T_OUT = 32 * 4, T_FMIX = 16 * 8, T_FOLD = 1024, T_TRIG = 512, T_POS = 32,
                T_MOD = 96;
  constexpr int B1 = T_IN, B2 = B1 + T_FOUT, B3 = B2 + T_DN, B4 = B3 + T_OUT, B5 = B4 + T_FMIX, B6 = B5 + T_FOLD,
                B7 = B6 + T_TRIG, B8 = B7 + T_POS, B9 = B8 + T_MOD;
  bool tab_built = false;
  const int t_lo = first_kind == 0 ? B7 : 0, t_hi = first_kind == 0 ? B9 : B7;
  for (int task0 = t_lo + blockIdx.x * 2; task0 < t_hi; task0 += gridDim.x * 2) {
    const int task = task0 + half;
    if (task < B1) {
      const int rt = task >> 2, kt = task & 3;
      const int row0 = 1024 + rt * 32;
      transpose_task4(P.w_in, 7200, wt1_srccol(row0), kt * 256, WT1 + (size_t)row0 * 1024, 1024, smem, t);
    } else if (task < B2) {
      const int id = task - B1, rt = id >> 1, kt = id & 1;
      transpose_task4(P.w_f_out, 1024, rt * 32, kt * 256, (u16*)(P.ws + OFF_WFOUT) + (size_t)(rt * 32) * 512, 512, smem, t);
    } else if (task < B3) {
      const int id = task - B2, rt = id >> 2, kt = id & 3;
      transpose_task4(P.w_dn_out, 1024, rt * 32, kt * 256, (u16*)(P.ws + OFF_WDN) + (size_t)(rt * 32) * 1024, 1024, smem, t);
    } else if (task < B4) {
      const int id = task - B3, rt = id >> 2, kt = id & 3;
      transpose_task4(P.w_out, 1024, rt * 32, kt * 256, (u16*)(P.ws + OFF_WOUT) + (size_t)(rt * 32) * 1024, 1024, smem, t);
    } else if (task < B5) {
      const int id = task - B4, rt = id >> 3, kt = id & 7;
      const int g = rt >> 2;
      u16* W = (u16*)(P.ws + OFF_WFMIX);
      if ((kt >> 1) == g)
        transpose_task(P.w_fmix + (size_t)g * 16384, 128, (rt & 3) * 32, (kt & 1) * 64, W + (size_t)(rt * 32) * 512 + g * 128, 512, smem, t);
      else
        transpose_task(P.w_fmix, 128, -1, kt * 64, W + (size_t)(rt * 32) * 512, 512, smem, t);
    } else if (task < B6) {
      const int id = task - B5, which = id >> 9, mblk = (id >> 4) & 31, dblk = id & 15;
      const int g = mblk >> 3;
      const int d0 = dblk * 64;
      float* Wsm = (float*)smem;
      float* tab = Wsm + 64 * 129;
#pragma unroll 1
      for (int ib = 0; ib < 32; ib += 8) {
        float rv[8];
#pragma unroll
        for (int q = 0; q < 8; ++q) { const int idx = t + 256 * (ib + q); rv[q] = P.w_in[(size_t)(d0 + (idx >> 7)) * 7200 + g * 128 + (idx & 127)]; }
#pragma unroll
        for (int q = 0; q < 8; ++q) { const int idx = t + 256 * (ib + q); Wsm[(idx >> 7) * 129 + (idx & 127)] = rv[q]; }
      }
      if (t < 128) tab[t] = which ? sinpif((float)t * (1.f / 64.f)) : cospif((float)t * (1.f / 64.f));
      __syncthreads();
      const int d = t & 63, mg = t >> 6;
      float* Cm = tab + 128;
#pragma unroll
      for (int e = 0; e < 4; ++e) {
        const int m = (mblk & 7) * 16 + mg * 4 + e;
        Cm[(mg * 4 + e) * 128 + d] = tab[(m * d) & 127];
        Cm[(mg * 4 + e) * 128 + 64 + d] = tab[(m * (64 + d)) & 127];
      }
      __syncthreads();
      float acc[4] = {0.f, 0.f, 0.f, 0.f};
#pragma unroll 2
      for (int c0 = 0; c0 < 128; c0 += 8) {
        float wv[8];
#pragma unroll
        for (int k = 0; k < 8; ++k) wv[k] = Wsm[d * 129 + c0 + k];
        f32x4 cl[4], ch[4];
#pragma unroll
        for (int e = 0; e < 4; ++e) {
          cl[e] = *(const f32x4*)(Cm + (mg * 4 + e) * 128 + c0);
          ch[e] = *(const f32x4*)(Cm + (mg * 4 + e) * 128 + c0 + 4);
        }
#pragma unroll
        for (int e = 0; e < 4; ++e) {
          acc[e] += wv[0] * cl[e][0] + wv[1] * cl[e][1] + wv[2] * cl[e][2] + wv[3] * cl[e][3];
          acc[e] += wv[4] * ch[e][0] + wv[5] * ch[e][1] + wv[6] * ch[e][2] + wv[7] * ch[e][3];
        }
      }
#pragma unroll
      for (int e = 0; e < 4; ++e) {
        const int m = (mblk & 7) * 16 + mg * 4 + e;
        WT1[(size_t)(which * 512 + g * 128 + m) * 1024 + d0 + d] = f2bf(acc[e]);
      }
      __syncthreads();
    } else if (task < B7) {
      float* tab = (float*)(smem + 40960);
      if (!tab_built) {
        for (int j = t; j < 4096; j += 256) tab[j] = cospif((float)j * (1.f / 2048.f));
        tab_built = true;
        __syncthreads();
      }
      u16* TRIG = (u16*)P.out + (size_t)4096 * 8192;
      const int id = task - B6;
      for (int rr = 0; rr < 8; ++rr) {
        const int k = id * 8 + rr;
#pragma unroll
        for (int p = 0; p < 2; ++p) {
          const int chunk = t + 256 * p;
          const int j0 = chunk * 8;
          float v[8];
#pragma unroll
          for (int e = 0; e < 8; ++e) {
            const int j = j0 + e;
            const int idx = (j <= 2048) ? ((k * j) & 4095) : ((k * (j - 2048) - 1024) & 4095);
            v[e] = (j <= 2048) ? tab[idx] : -tab[idx];
          }
          u32x4 o;
#pragma unroll
          for (int e = 0; e < 4; ++e) o[e] = pk2(v[2 * e], v[2 * e + 1]);
          *(u32x4*)(TRIG + (size_t)k * 4096 + j0) = o;
        }
      }
    } else if (task < B8) {
      const int id = task - B7;
      float* POS = (float*)(P.ws + OFF_POS);
#pragma unroll 1
      for (int q = 0; q < 8; ++q) {
        const int e = id * 2048 + q * 256 + t;
        const int p = (e >> 9) & 63, d = e & 511, i = d & 255;
        const float omega = 1.0f / powf(10000.0f, (float)i * (1.f / 256.f));
        const float a = (float)p * omega;
        POS[e] = (d < 256) ? sinf(a) : cosf(a);
      }
    } else {
      const int id = task - B8;
      __syncthreads();
      float* sc = (float*)smem;
#pragma unroll 1
      for (int ib = 0; ib < 36; ib += 12) {
        float rv[12];
#pragma unroll
        for (int q = 0; q < 12; ++q) {
          const int idx = t + 256 * (ib + q);
          const int v = idx >> 10, k = idx & 1023;
          rv[q] = (v < 8) ? P.c[v * 1024 + k] : P.c_ctx[k];
        }
#pragma unroll
        for (int q = 0; q < 12; ++q) sc[t + 256 * (ib + q)] = silu_f(rv[q]);
      }
      __syncthreads();
      const int col = id * 32 + (t & 31), part = t >> 5;
      float a[9];
#pragma unroll
      for (int v = 0; v < 9; ++v) a[v] = 0.f;
#pragma unroll 1
      for (int kb = 0; kb < 128; kb += 16) {
        float wv[16];
#pragma unroll
        for (int q = 0; q < 16; ++q) wv[q] = P.w_mod[(size_t)(part * 128 + kb + q) * 3072 + col];
#pragma unroll
        for (int q = 0; q < 16; ++q)
#pragma unroll
          for (int v = 0; v < 9; ++v) a[v] += sc[v * 1024 + part * 128 + kb + q] * wv[q];
      }
      float* red = (float*)(smem + 40960);
#pragma unroll
      for (int v = 0; v < 9; ++v) red[(part * 9 + v) * 32 + (t & 31)] = a[v];
      __syncthreads();
      {
        float* MOD = (float*)(P.ws + OFF_MOD);
#pragma unroll 1
        for (int o = t; o < 288; o += 256) {
          const int v = o >> 5, cc = o & 31;
          float pr[8];
#pragma unroll
          for (int pp = 0; pp < 8; ++pp) pr[pp] = red[(pp * 9 + v) * 32 + cc];
          float sum = P.b_mod[id * 32 + cc];
#pragma unroll
          for (int pp = 0; pp < 8; ++pp) sum += pr[pp];
          MOD[v * 3072 + id * 32 + cc] = sum;
        }
      }
      __syncthreads();
      tab_built = false;
    }
  }
}

DI void phase_preadd(const Params& P) {
  const int t = ltid();
  const u16* YT = (const u16*)P.out;
  u16* YS = (u16*)P.out + (size_t)4096 * 8192 + (size_t)4096 * 4096;
  const int j0 = t * 8;
  const bool cospart = t < 256;
  const int base_a = cospart ? j0 : (4096 + j0 - 2048);
  const int base_m = cospart ? (4096 - j0) : (8192 - (j0 - 2048));
  const float sgn = cospart ? 1.f : -1.f;
  const bool has_c = (t != 0) && (t != 256);
  for (int it = blockIdx.x; it < 4096; it += gridDim.x) {
    const u16* yr = YT + (size_t)it * 8192;
    const u32x4 A = __builtin_nontemporal_load((const u32x4*)(yr + base_a));
    const u32x4 B = __builtin_nontemporal_load((const u32x4*)(yr + base_m - 8));
    const float c0 = has_c ? bf2f(yr[base_m]) : 0.f;
    const float mid = bf2f(yr[2048]);
    float a[8], m[8];
#pragma unroll
    for (int e = 0; e < 4; ++e) { a[2 * e] = bflo(A[e]); a[2 * e + 1] = bfhi(A[e]); m[2 * e] = bflo(B[e]); m[2 * e + 1] = bfhi(B[e]); }
    float v[8];
    v[0] = a[0] + sgn * c0;
#pragma unroll
    for (int e = 1; e < 8; ++e) v[e] = a[e] + sgn * m[8 - e];
    if (t == 256) v[0] = mid;
    u32x4 o;
#pragma unroll
    for (int e = 0; e < 4; ++e) o[e] = pk2(v[2 * e], v[2 * e + 1]);
    *(u32x4*)(YS + (size_t)it * 4096 + j0) = o;
  }
}

DI void phase_ln_mod(const Params& P) {
  const int t = ltid(), lane = t & 63, w = t >> 6;
  const float* POS = (const float*)(P.ws + OFF_POS);
  const float* MOD = (const float*)(P.ws + OFF_MOD);
  u16* H = (u16*)(P.ws + OFF_H);
  for (int row = blockIdx.x * 8 + w; row < NROWS; row += gridDim.x * 8) {
    const bool lat = row < NLAT;
    const float* src = lat ? (P.x + (size_t)row * 1024) : (P.ctx + (size_t)(row - NLAT) * 1024);
    const int n = row & 4095, pr = n >> 6, pc = n & 63;
    float v[16];
    float4 xa[4], xq[4];
#pragma unroll
    for (int i = 0; i < 4; ++i) {
      const int col = lane * 4 + 256 * i;
      xa[i] = *(const float4*)(src + col);
      xq[i] = *(const float4*)((col < 512) ? (POS + pr * 512 + col) : (POS + 32768 + pc * 512 + (col - 512)));
    }
    __builtin_amdgcn_sched_barrier(0);
    const float pm = lat ? 1.f : 0.f;
#pragma unroll
    for (int i = 0; i < 4; ++i) {
      v[4 * i] = xa[i].x + pm * xq[i].x; v[4 * i + 1] = xa[i].y + pm * xq[i].y;
      v[4 * i + 2] = xa[i].z + pm * xq[i].z; v[4 * i + 3] = xa[i].w + pm * xq[i].w;
    }
    float s = 0.f;
#pragma unroll
    for (int i = 0; i < 16; ++i) s += v[i];
    const float mean = wave_sum(s) * (1.f / 1024.f);
    float q = 0.f;
#pragma unroll
    for (int i = 0; i < 16; ++i) { const float d = v[i] - mean; q += d * d; }
    const float rstd = rsqrtf(wave_sum(q) * (1.f / 1024.f) + 1e-6f);
    const float* mr = MOD + (lat ? (row >> 12) : 8) * 3072;
    float4 shv[4], sclv[4];
#pragma unroll
    for (int i = 0; i < 4; ++i) { shv[i] = *(const float4*)(mr + lane * 4 + 256 * i); sclv[i] = *(const float4*)(mr + 1024 + lane * 4 + 256 * i); }
    __builtin_amdgcn_sched_barrier(0);
#pragma unroll
    for (int i = 0; i < 4; ++i) {
      const int col = lane * 4 + 256 * i;
      const float4 sh = shv[i];
      const float4 scl = sclv[i];
      const float h0 = (v[4 * i] - mean) * rstd * (1.f + scl.x) + sh.x;
      const float h1 = (v[4 * i + 1] - mean) * rstd * (1.f + scl.y) + sh.y;
      const float h2 = (v[4 * i + 2] - mean) * rstd * (1.f + scl.z) + sh.z;
      const float h3 = (v[4 * i + 3] - mean) * rstd * (1.f + scl.w) + sh.w;
      u32x2 o = {pk2(h0, h1), pk2(h2, h3)};
      *(u32x2*)(H + (size_t)row * 1024 + col) = o;
    }
  }
}

DI void lds_barrier() { asm volatile("s_waitcnt lgkmcnt(0)" ::: "memory"); __builtin_amdgcn_s_barrier(); asm volatile("" ::: "memory"); }
DI int tswz(int row, int i) { return row * 72 + ((((i >> 3) ^ ((row >> 3) & 7)) << 3) | (i & 7)); }
DI void prep_unit(const Params& P, int b, int h, int dir, int cs, int isctx, int slot, int cj, char* smem, int t, int solver_w) {
  asm volatile("" : "+v"(t));
  const int lane = t & 63, w = t >> 6;
  const int fr = lane & 31, fh = lane >> 5;
  const int nchunks = isctx ? 4 : 64;
  const int corig = dir ? (nchunks - 1 - cs) : cs;
  const int seqlen = isctx ? 256 : 4096;
  const size_t rowbase = isctx ? (size_t)(NLAT + b * 256) : (size_t)(b * 4096);
  const int r0 = corig * 64;
  const int scan_id = (b * 8 + h) * 2 + dir;
  const u16* QKV = (const u16*)(P.ws + OFF_QKV);
  const float* BD = (const float*)(P.ws + OFF_BD);
  char* blob = P.ws + OFF_OPBUF + (size_t)slot * OPBUF_SLOT + (size_t)(scan_id * 8 + cj) * BLOB;
  u16* q_s = (u16*)(smem);
  u16* k_s = (u16*)(smem + 17408);
  u16* kT_s = (u16*)(smem + 34816);
  u16* vT_s = (u16*)(smem + 53248);
  float* sc = (float*)(smem + 71680);
  float* A_s = (float*)smem;
  u16* Tu_s = (u16*)(smem + 16384);
  u16* Tw_s = (u16*)(smem + 25600);

  float braw = 0.f, draw = 0.f;
  if (w == 0) {
    const int rloc0 = dir ? (63 - lane) : lane;
    const size_t grow = rowbase + r0 + rloc0;
    braw = BD[grow * 32 + dir * 8 + h];
    draw = BD[grow * 32 + 16 + dir * 8 + h];
  }
  {
    const int cg8 = (t & 15) * 8, rg = t >> 4;
    u32x4 xr[3][6];
    f32x4 cw[3][3][2];
#pragma unroll
    for (int part = 0; part < 3; ++part) {
      const int colbase = part * 1024 + h * 128 + cg8;
#pragma unroll
      for (int rr = 0; rr < 6; ++rr) {
        const int r = r0 + rg * 4 - 1 + rr;
        u32x4 v = {0u, 0u, 0u, 0u};
        if (r >= 0 && r < seqlen) v = *(const u32x4*)(QKV + (rowbase + r) * 3072 + colbase);
        xr[part][rr] = v;
      }
#pragma unroll
      for (int tap = 0; tap < 3; ++tap) {
        cw[part][tap][0] = *(const f32x4*)(P.conv_w + tap * 3072 + colbase);
        cw[part][tap][1] = *(const f32x4*)(P.conv_w + tap * 3072 + colbase + 4);
      }
    }
#pragma unroll
    for (int part = 0; part < 3; ++part) {
      float y[4][8];
#pragma unroll
      for (int a = 0; a < 4; ++a) {
        float ss = 0.f;
#pragma unroll
        for (int e = 0; e < 8; ++e) {
          const float x0 = (e & 1) ? bfhi(xr[part][a][e >> 1]) : bflo(xr[part][a][e >> 1]);
          const float x1 = (e & 1) ? bfhi(xr[part][a + 1][e >> 1]) : bflo(xr[part][a + 1][e >> 1]);
          const float x2 = (e & 1) ? bfhi(xr[part][a + 2][e >> 1]) : bflo(xr[part][a + 2][e >> 1]);
          const float z = x0 * cw[part][0][e >> 2][e & 3] + x1 * cw[part][1][e >> 2][e & 3] + x2 * cw[part][2][e >> 2][e & 3];
          y[a][e] = silu_f(z);
          ss += y[a][e] * y[a][e];
        }
        if (part < 2) {
          ss = sum16(ss);
          const float inv = rsqrtf(ss + 1e-6f);
#pragma unroll
          for (int e = 0; e < 8; ++e) y[a][e] *= inv;
        }
        if (part < 2) {
          const int rloc = rg * 4 + a;
          const int i = dir ? (63 - rloc) : rloc;
          u32x4 pv = {pk2(y[a][0], y[a][1]), pk2(y[a][2], y[a][3]), pk2(y[a][4], y[a][5]), pk2(y[a][6], y[a][7])};
          *(u32x4*)((part == 0 ? q_s : k_s) + i * 136 + cg8) = pv;
        }
      }
      if (part >= 1) {
        u16* dstT = (part == 1) ? kT_s : vT_s;
        const int i0 = dir ? (60 - rg * 4) : (rg * 4);
#pragma unroll
        for (int e = 0; e < 8; ++e) {
          const float v0 = dir ? y[3][e] : y[0][e], v1 = dir ? y[2][e] : y[1][e];
          const float v2 = dir ? y[1][e] : y[2][e], v3 = dir ? y[0][e] : y[3][e];
          u32x2 pv = {pk2(v0, v1), pk2(v2, v3)};
          *(u32x2*)(dstT + tswz(cg8 + e, i0)) = pv;
        }
      }
    }
  }
  if (w == 0) {
    const int i = lane;
    const float beta = sigm_f(braw);
    const float xx = draw + P.dt_bias[dir * 8 + h];
    const float sp = (xx > 20.f) ? xx : log1pf(expf(xx));
    float s = -expf(P.a_log[dir * 8 + h]) * sp;
#pragma unroll
    for (int d = 1; d < 64; d <<= 1) {
      const float o = __shfl_up(s, d);
      if (lane >= d) s += o;
    }
    sc[i] = beta;
    sc[64 + i] = s;
  }
  lds_barrier();

  const float gcl = sc[64 + 63];
  f32x16 kk = zero16();
  {
    const int ti = w >> 1, tj = w & 1;
    if (w != 1) {
      bf16x8 fa[8], fb[8];
#pragma unroll
      for (int s8 = 0; s8 < 8; ++s8) {
        fa[s8] = *(const bf16x8*)(k_s + (ti * 32 + fr) * 136 + s8 * 16 + fh * 8);
        fb[s8] = *(const bf16x8*)(k_s + (tj * 32 + fr) * 136 + s8 * 16 + fh * 8);
      }
      __builtin_amdgcn_sched_barrier(0);
#pragma unroll
      for (int s8 = 0; s8 < 8; ++s8) kk = MFMA(fa[s8], fb[s8], kk);
    }
    if (w != 2) {
      const int tj2 = w >> 1, ti2 = w & 1;
      f32x16 qkt = zero16();
      {
        bf16x8 fa[8], fb[8];
#pragma unroll
        for (int s8 = 0; s8 < 8; ++s8) {
          fa[s8] = *(const bf16x8*)(k_s + (tj2 * 32 + fr) * 136 + s8 * 16 + fh * 8);
          fb[s8] = *(const bf16x8*)(q_s + (ti2 * 32 + fr) * 136 + s8 * 16 + fh * 8);
        }
        __builtin_amdgcn_sched_barrier(0);
#pragma unroll
        for (int s8 = 0; s8 < 8; ++s8) qkt = MFMA(fa[s8], fb[s8], qkt);
      }
      const int i = ti2 * 32 + fr;
      const float gci = sc[64 + i];
      f32x16 val;
      float gcj[16];
#pragma unroll
      for (int g = 0; g < 16; ++g) gcj[g] = sc[64 + tj2 * 32 + crow(g, fh)];
#pragma unroll
      for (int g = 0; g < 16; ++g) {
        const int j = tj2 * 32 + crow(g, fh);
        val[g] = (i >= j) ? qkt[g] * 0.08838834764831845f * __expf(gci - gcj[g]) : 0.f;
      }
#pragma unroll
      for (int s = 0; s < 2; ++s) {
        bf16x8 pv = pack_step(val, s);
        __builtin_nontemporal_store((bf16x8)(pv), (bf16x8*)(blob + 49152 + (size_t)((((ti2 * 2 + tj2) * 2 + s) * 64 + lane) * 16)));
      }
    }
  }
#pragma unroll
  for (int p = 0; p < 4; ++p) {
    const int idx = t + 256 * p;
    const int ln = idx & 63, s = (idx >> 6) & 1, tk = (idx >> 7) & 3, ti = idx >> 9;
    const int i = ti * 32 + (ln & 31), hh = ln >> 5;
    const int dk0 = tk * 32 + 16 * s + 4 * hh;
    const u32x2 lo = *(const u32x2*)(q_s + i * 136 + dk0);
    const u32x2 hi = *(const u32x2*)(q_s + i * 136 + dk0 + 8);
    const float sci = 0.08838834764831845f * __expf(sc[64 + i]);
    u32x4 o = {pk2(bflo(lo[0]) * sci, bfhi(lo[0]) * sci), pk2(bflo(lo[1]) * sci, bfhi(lo[1]) * sci),
               pk2(bflo(hi[0]) * sci, bfhi(hi[0]) * sci), pk2(bflo(hi[1]) * sci, bfhi(hi[1]) * sci)};
    __builtin_nontemporal_store((u32x4)(o), (u32x4*)(blob + 16384 + (size_t)idx * 16));
  }
#pragma unroll
  for (int p = 0; p < 4; ++p) {
    const int idx = t + 256 * p;
    const int ln = idx & 63, s = (idx >> 6) & 1, ti = (idx >> 7) & 1, tm = idx >> 8;
    const int dk = tm * 32 + (ln & 31), hh = ln >> 5;
    const int i0 = ti * 32 + 16 * s + 4 * hh;
    const u32x2 lo = *(const u32x2*)(kT_s + tswz(dk, i0));
    const u32x2 hi = *(const u32x2*)(kT_s + tswz(dk, i0 + 8));
    const float4 ga = *(const float4*)(sc + 64 + i0), gb = *(const float4*)(sc + 64 + i0 + 8);
    const float e0 = __expf(gcl - ga.x), e1 = __expf(gcl - ga.y), e2 = __expf(gcl - ga.z), e3 = __expf(gcl - ga.w);
    const float e4 = __expf(gcl - gb.x), e5 = __expf(gcl - gb.y), e6 = __expf(gcl - gb.z), e7 = __expf(gcl - gb.w);
    u32x4 o = {pk2(bflo(lo[0]) * e0, bfhi(lo[0]) * e1), pk2(bflo(lo[1]) * e2, bfhi(lo[1]) * e3),
               pk2(bflo(hi[0]) * e4, bfhi(hi[0]) * e5), pk2(bflo(hi[1]) * e6, bfhi(hi[1]) * e7)};
    __builtin_nontemporal_store((u32x4)(o), (u32x4*)(blob + 32768 + (size_t)idx * 16));
  }
  lds_barrier();

  if (w != 1) {
    const int ti = w >> 1, tj = w & 1;
    const int j = tj * 32 + fr;
    const float gcj = sc[64 + j];
    float bi[16], gi[16];
#pragma unroll
    for (int g = 0; g < 16; ++g) { bi[g] = sc[ti * 32 + crow(g, fh)]; gi[g] = sc[64 + ti * 32 + crow(g, fh)]; }
#pragma unroll
    for (int g = 0; g < 16; ++g) {
      const int i = ti * 32 + crow(g, fh);
      A_s[i * 64 + j] = (i > j) ? bi[g] * kk[g] * __expf(gi[g] - gcj) : 0.f;
    }
  }
  lds_barrier();

  if (w == solver_w) {
    const int cl = lane & 31, hb2 = lane >> 5;
    const float* Ab = A_s + hb2 * (32 * 64 + 32);
    float tt[32];
    {
      float4 Lc[8], Ln[8];
      tt[0] = (cl == 0) ? 1.f : 0.f;
      Lc[0] = *(const float4*)(Ab + 64);
#pragma unroll
      for (int i = 1; i < 32; ++i) {
        if (i + 1 < 32) {
#pragma unroll
          for (int j4 = 0; j4 < (i + 4) / 4; ++j4) Ln[j4] = *(const float4*)(Ab + (i + 1) * 64 + j4 * 4);
        }
        __builtin_amdgcn_sched_barrier(0);
        float s0 = 0.f, s1 = 0.f, s2 = 0.f, s3 = 0.f;
#pragma unroll
        for (int j4 = 0; j4 < (i + 3) / 4; ++j4) {
          const float4 l = Lc[j4];
          if (j4 * 4 + 0 < i) s0 += l.x * tt[j4 * 4 + 0];
          if (j4 * 4 + 1 < i) s1 += l.y * tt[j4 * 4 + 1];
          if (j4 * 4 + 2 < i) s2 += l.z * tt[j4 * 4 + 2];
          if (j4 * 4 + 3 < i) s3 += l.w * tt[j4 * 4 + 3];
        }
        tt[i] = ((cl == i) ? 1.f : 0.f) - ((s0 + s1) + (s2 + s3));
        __builtin_amdgcn_sched_barrier(0);
        if (i + 1 < 32) {
#pragma unroll
          for (int j4 = 0; j4 < (i + 4) / 4; ++j4) Lc[j4] = Ln[j4];
        }
      }
    }
    u16* T11T = (u16*)(smem + 16384);
    u16* T22r = (u16*)(smem + 16384 + 2560);
    if (hb2 == 0) {
#pragma unroll
      for (int q = 0; q < 4; ++q) {
        u32x4 pv = {pk2(tt[8 * q], tt[8 * q + 1]), pk2(tt[8 * q + 2], tt[8 * q + 3]), pk2(tt[8 * q + 4], tt[8 * q + 5]), pk2(tt[8 * q + 6], tt[8 * q + 7])};
        *(u32x4*)(T11T + cl * 40 + 8 * q) = pv;
      }
    } else {
#pragma unroll
      for (int i = 0; i < 32; ++i) T22r[i * 40 + cl] = f2bf(tt[i]);
    }
    asm volatile("s_waitcnt lgkmcnt(0)" ::: "memory");
    f32x16 Pm = zero16();
#pragma unroll
    for (int s2 = 0; s2 < 2; ++s2) {
      const float4 la = *(const float4*)(A_s + (32 + cl) * 64 + 16 * s2 + 8 * hb2);
      const float4 lb = *(const float4*)(A_s + (32 + cl) * 64 + 16 * s2 + 8 * hb2 + 4);
      u32x4 av = {pk2(la.x, la.y), pk2(la.z, la.w), pk2(lb.x, lb.y), pk2(lb.z, lb.w)};
      const bf16x8 bfr = *(const bf16x8*)(T11T + cl * 40 + 16 * s2 + 8 * hb2);
      Pm = MFMA(__builtin_bit_cast(bf16x8, av), bfr, Pm);
    }
    f32x16 Rm = zero16();
#pragma unroll
    for (int s2 = 0; s2 < 2; ++s2) {
      const bf16x8 pb = pack_step(Pm, s2);
      const int k0 = 16 * s2 + 4 * hb2;
      const u32x2 lo = *(const u32x2*)(T22r + cl * 40 + k0);
      const u32x2 hi = *(const u32x2*)(T22r + cl * 40 + k0 + 8);
      u32x4 av = {lo[0], lo[1], hi[0], hi[1]};
      Rm = MFMA(__builtin_bit_cast(bf16x8, av), pb, Rm);
    }
    asm volatile("s_waitcnt lgkmcnt(0)" ::: "memory");
    const float bcA = sc[lane], bgeA = -bcA * __expf(sc[64 + lane]);
    const float bcB = sc[cl], bgeB = -bcB * __expf(sc[64 + cl]);
#pragma unroll
    for (int i = 0; i < 32; ++i) {
      const float top = hb2 ? 0.f : tt[i];
      Tu_s[i * 72 + lane] = f2bf(top * bcA);
      Tw_s[i * 72 + lane] = f2bf(top * bgeA);
    }
    if (hb2) {
#pragma unroll
      for (int i = 0; i < 32; ++i) {
        Tu_s[(32 + i) * 72 + lane] = f2bf(tt[i] * bcA);
        Tw_s[(32 + i) * 72 + lane] = f2bf(tt[i] * bgeA);
      }
    }
#pragma unroll
    for (int g = 0; g < 16; ++g) {
      const int row = 32 + crow(g, hb2);
      Tu_s[row * 72 + cl] = f2bf(-Rm[g] * bcB);
      Tw_s[row * 72 + cl] = f2bf(-Rm[g] * bgeB);
    }
  }
  lds_barrier();

#pragma unroll
  for (int ti = 0; ti < 2; ++ti) {
    f32x16 au = zero16(), aw = zero16();
    {
      bf16x8 f1[4], f2[4], f3[4], f4[4];
#pragma unroll
      for (int s4 = 0; s4 < 4; ++s4) {
        f1[s4] = *(const bf16x8*)(Tu_s + (ti * 32 + fr) * 72 + s4 * 16 + fh * 8);
        f2[s4] = *(const bf16x8*)(vT_s + tswz(w * 32 + fr, s4 * 16 + fh * 8));
        f3[s4] = *(const bf16x8*)(kT_s + tswz(w * 32 + fr, s4 * 16 + fh * 8));
        f4[s4] = *(const bf16x8*)(Tw_s + (ti * 32 + fr) * 72 + s4 * 16 + fh * 8);
      }
      __builtin_amdgcn_sched_barrier(0);
#pragma unroll
      for (int s4 = 0; s4 < 4; ++s4) {
        au = MFMA(f1[s4], f2[s4], au);
        aw = MFMA(f3[s4], f4[s4], aw);
      }
    }
    bf16x8 u0 = pack_step(au, 0), u1 = pack_step(au, 1);
    char* up = blob + 57344 + (size_t)(((ti * 4 + w) * 64 + lane) * 32);
    __builtin_nontemporal_store((bf16x8)(u0), (bf16x8*)(up));
    __builtin_nontemporal_store((bf16x8)(u1), (bf16x8*)(up + 16));
#pragma unroll
    for (int s = 0; s < 2; ++s) {
      bf16x8 pv = pack_step(aw, s);
      __builtin_nontemporal_store((bf16x8)(pv), (bf16x8*)(blob + (size_t)((((ti * 4 + w) * 2 + s) * 64 + lane) * 16)));
    }
  }
  if (t == 0) ((float*)(P.ws + OFF_GL))[(slot * 128 + scan_id) * 8 + cj] = __expf(gcl);
  lds_barrier();
}

DI void prep_segment(const Params& P, int seg, char* smem_all, volatile LAS unsigned* xst) {
  const int tt = ltid();
  const int half = tt >> 8, t = tt & 255;
  char* smem = smem_all + half * HALF_SMEM;
  const int nch = seg == 0 ? 4 : 8;
  const unsigned total_pairs = 64u * nch;
  unsigned* cnt = (unsigned*)(P.ws + OFF_BAR + 16384) + seg * 64;
  for (;;) {
    if (tt == 0) xst[2] = __hip_atomic_fetch_add(cnt, 1u, __ATOMIC_RELAXED, __HIP_MEMORY_SCOPE_AGENT);
    lds_barrier();
    const unsigned pair = xst[2];
    if (pair >= total_pairs) break;
    const int u = (int)pair * 2 + half;
    const int cj = u % nch, sid = u / nch;
    const int b = sid >> 4, h = (sid >> 1) & 7, dir = sid & 1;
    const int cs = seg == 0 ? cj : (seg - 1) * 8 + cj;
    prep_unit(P, b, h, dir, cs, seg == 0, seg & 1, cj, smem, t, half);
  }
}

DI void scan_segment(const Params& P, int seg, char* smem) {
  const int tt = ltid();
  const int half = tt >> 8, t = tt & 255, lane = t & 63, w = t >> 6;
  const int fr = lane & 31, fh = lane >> 5;
  const int sb = blockIdx.x;
  const int b = sb >> 4, h = (sb >> 1) & 7, dir = sb & 1;
  const int nch = seg == 0 ? 4 : 8, slot = seg & 1;
  float* ST = (float*)(P.ws + OFF_STATE) + (size_t)((sb * 4 + w) * 4) * 1024;
  const float* GL = (const float*)(P.ws + OFF_GL) + (slot * 128 + sb) * 8;
  u16* OB = (u16*)P.out + (size_t)dir * NLAT * 1024;
  const char* blob0 = P.ws + OFF_OPBUF + (size_t)slot * OPBUF_SLOT + (size_t)(sb * 8) * BLOB;
  f32x16 S[4];
  u32x4 un[2][2];
  if (half == 0) {
#pragma unroll
    for (int tm = 0; tm < 4; ++tm) {
      if (seg == 0) S[tm] = zero16();
      else {
#pragma unroll
        for (int q = 0; q < 4; ++q) {
          const float4 v = *(const float4*)(ST + tm * 1024 + lane * 16 + q * 4);
          S[tm][4 * q] = v.x; S[tm][4 * q + 1] = v.y; S[tm][4 * q + 2] = v.z; S[tm][4 * q + 3] = v.w;
        }
      }
    }
#pragma unroll
    for (int ti = 0; ti < 2; ++ti) {
      const char* up = blob0 + 57344 + (size_t)(((ti * 4 + w) * 64 + lane) * 32);
      un[ti][0] = *(const u32x4*)up;
      un[ti][1] = *(const u32x4*)(up + 16);
    }
  } else {
    u32x4 tmp[14];
#pragma unroll
    for (int p = 0; p < 14; ++p) tmp[p] = __builtin_nontemporal_load((const u32x4*)(blob0 + (size_t)(t + 256 * p) * 16));
#pragma unroll
    for (int p = 0; p < 14; ++p) *(u32x4*)(smem + (t + 256 * p) * 16) = tmp[p];
  }
  lds_barrier();
#pragma unroll 1
  for (int cj = 0; cj < nch; ++cj) {
    const char* sbuf = smem + (cj & 1) * 65536;
    if (half == 1) {
      if (cj + 1 < nch) {
        const char* blob = blob0 + (size_t)(cj + 1) * BLOB;
        char* dbuf = smem + ((cj + 1) & 1) * 65536;
        u32x4 tmp[14];
#pragma unroll
        for (int p = 0; p < 14; ++p) tmp[p] = __builtin_nontemporal_load((const u32x4*)(blob + (size_t)(t + 256 * p) * 16));
#pragma unroll
        for (int p = 0; p < 14; ++p) *(u32x4*)(dbuf + (t + 256 * p) * 16) = tmp[p];
      }
    } else {
      f32x16 vn[2];
#pragma unroll
      for (int ti = 0; ti < 2; ++ti)
#pragma unroll
        for (int e = 0; e < 4; ++e) {
          vn[ti][2 * e] = bflo(un[ti][0][e]); vn[ti][2 * e + 1] = bfhi(un[ti][0][e]);
          vn[ti][8 + 2 * e] = bflo(un[ti][1][e]); vn[ti][8 + 2 * e + 1] = bfhi(un[ti][1][e]);
        }
      const float glv = GL[cj];
      if (cj + 1 < nch) {
        const char* blob = blob0 + (size_t)(cj + 1) * BLOB;
#pragma unroll
        for (int ti = 0; ti < 2; ++ti) {
          const char* up = blob + 57344 + (size_t)(((ti * 4 + w) * 64 + lane) * 32);
          un[ti][0] = *(const u32x4*)up;
          un[ti][1] = *(const u32x4*)(up + 16);
        }
      }
      bf16x8 Sb[4][2];
#pragma unroll
      for (int tm = 0; tm < 4; ++tm) { Sb[tm][0] = pack_step(S[tm], 0); Sb[tm][1] = pack_step(S[tm], 1); }
      f32x16 o[2];
      o[0] = zero16(); o[1] = zero16();
      {
        bf16x8 fa[2][4];
#pragma unroll
        for (int s = 0; s < 2; ++s) {
          fa[0][s] = *(const bf16x8*)(sbuf + ((s) * 64 + lane) * 16);
          fa[0][2 + s] = *(const bf16x8*)(sbuf + 16384 + ((s) * 64 + lane) * 16);
        }
#pragma unroll
        for (int idx = 0; idx < 8; ++idx) {
          const int ti = idx >> 2, tk = idx & 3;
          if (idx + 1 < 8) {
            const int ti2 = (idx + 1) >> 2, tk2 = (idx + 1) & 3;
#pragma unroll
            for (int s = 0; s < 2; ++s) {
              const int fo = (((ti2 * 4 + tk2) * 2 + s) * 64 + lane) * 16;
              fa[(idx + 1) & 1][s] = *(const bf16x8*)(sbuf + fo);
              fa[(idx + 1) & 1][2 + s] = *(const bf16x8*)(sbuf + 16384 + fo);
            }
          }
          __builtin_amdgcn_sched_barrier(0);
#pragma unroll
          for (int s = 0; s < 2; ++s) {
            vn[ti] = MFMA(fa[idx & 1][s], Sb[tk][s], vn[ti]);
            o[ti] = MFMA(fa[idx & 1][2 + s], Sb[tk][s], o[ti]);
          }
          __builtin_amdgcn_sched_barrier(0);
        }
      }
      bf16x8 vb[2][2];
#pragma unroll
      for (int ti = 0; ti < 2; ++ti) { vb[ti][0] = pack_step(vn[ti], 0); vb[ti][1] = pack_step(vn[ti], 1); }
      {
        bf16x8 fq[6];
#pragma unroll
        for (int q = 0; q < 6; ++q) {
          const int ti = (q >= 2) ? 1 : 0, tj = (q >= 4) ? 1 : 0, s = q & 1;
          fq[q] = *(const bf16x8*)(sbuf + 49152 + (((ti * 2 + tj) * 2 + s) * 64 + lane) * 16);
        }
        bf16x8 fk[2][4];
#pragma unroll
        for (int q = 0; q < 4; ++q) fk[0][q] = *(const bf16x8*)(sbuf + 32768 + (q * 64 + lane) * 16);
        __builtin_amdgcn_sched_barrier(0);
#pragma unroll
        for (int q = 0; q < 6; ++q) {
          const int ti = (q >= 2) ? 1 : 0, tj = (q >= 4) ? 1 : 0, s = q & 1;
          o[ti] = MFMA(fq[q], vb[tj][s], o[ti]);
        }
#pragma unroll
        for (int tm = 0; tm < 4; ++tm) {
          if (tm + 1 < 4) {
#pragma unroll
            for (int q = 0; q < 4; ++q) fk[(tm + 1) & 1][q] = *(const bf16x8*)(sbuf + 32768 + ((((tm + 1) * 4) + q) * 64 + lane) * 16);
          }
          __builtin_amdgcn_sched_barrier(0);
#pragma unroll
          for (int g = 0; g < 16; ++g) S[tm][g] *= glv;
#pragma unroll
          for (int q = 0; q < 4; ++q) S[tm] = MFMA(fk[tm & 1][q], vb[q >> 1][q & 1], S[tm]);
          __builtin_amdgcn_sched_barrier(0);
        }
      }
      if (seg > 0) {
        const int cs = (seg - 1) * 8 + cj;
        const int corig = dir ? (63 - cs) : cs;
        int sgn = dir ? -1024 : 1024;
        asm volatile("" : "+v"(sgn));
        const int base_idx = (b * 4096 + corig * 64 + (dir ? (63 - 4 * fh) : (4 * fh))) * 1024 + h * 128 + w * 32 + fr;
#pragma unroll
        for (int ti = 0; ti < 2; ++ti)
#pragma unroll
          for (int g = 0; g < 16; ++g) {
            const int idx = base_idx + sgn * (ti * 32 + (g & 3) + 8 * (g >> 2));
            __builtin_nontemporal_store(f2bf(o[ti][g]), OB + idx);
          }
      }
    }
    lds_barrier();
  }
  if (half == 0) {
#pragma unroll
    for (int tm = 0; tm < 4; ++tm)
#pragma unroll
      for (int q = 0; q < 4; ++q) {
        float4 v = {S[tm][4 * q], S[tm][4 * q + 1], S[tm][4 * q + 2], S[tm][4 * q + 3]};
        *(float4*)(ST + tm * 1024 + lane * 16 + q * 4) = v;
      }
  }
}

DI void phase_od(const Params& P) {
  const int t = ltid();
  const u16* GATES = (const u16*)(P.ws + OFF_GATES);
  const u16* OF = (const u16*)P.out;
  const u16* OBk = (const u16*)P.out + (size_t)NLAT * 1024;
  u16* OD = (u16*)(P.ws + OFF_OD);
  const int d0 = (t & 15) * 8;
  float nw[8];
#pragma unroll
  for (int e = 0; e < 8; ++e) nw[e] = P.dn_norm_w[d0 + e];
  for (int it0 = blockIdx.x; it0 < NLAT * 8 / 32; it0 += gridDim.x * 4) {
    u32x4 a[4], bq[4], gt[4];
    size_t off[4];
#pragma unroll
    for (int u = 0; u < 4; ++u) {
      const int it = it0 + u * gridDim.x;
      const bool ok = it < NLAT * 8 / 32;
      const int pair = (ok ? it : it0) * 32 + (t >> 4);
      const size_t token = pair >> 3;
      const int hh = pair & 7;
      off[u] = token * 1024 + hh * 128 + d0;
      a[u] = __builtin_nontemporal_load((const u32x4*)(OF + off[u]));
      bq[u] = __builtin_nontemporal_load((const u32x4*)(OBk + off[u]));
      gt[u] = *(const u32x4*)(GATES + token * 3584 + 512 + hh * 128 + d0);
    }
#pragma unroll
    for (int u = 0; u < 4; ++u) {
      const int it = it0 + u * gridDim.x;
      float o[8];
      float ss = 0.f;
#pragma unroll
      for (int e = 0; e < 4; ++e) {
        o[2 * e] = bflo(a[u][e]) + bflo(bq[u][e]);
        o[2 * e + 1] = bfhi(a[u][e]) + bfhi(bq[u][e]);
        ss += o[2 * e] * o[2 * e] + o[2 * e + 1] * o[2 * e + 1];
      }
      ss = sum16(ss);
      const float r = rsqrtf(ss * (1.f / 128.f) + 1e-6f);
      u32x4 ov;
#pragma unroll
      for (int e = 0; e < 4; ++e)
        ov[e] = pk2(o[2 * e] * r * nw[2 * e] * bflo(gt[u][e]), o[2 * e + 1] * r * nw[2 * e + 1] * bfhi(gt[u][e]));
      if (it < NLAT * 8 / 32) *(u32x4*)(OD + off[u]) = ov;
    }
  }
}

DI void phase_final_ln(const Params& P) {
  const int t = ltid(), lane = t & 63, w = t >> 6;
  const float* POS = (const float*)(P.ws + OFF_POS);
  const u16* G = (const u16*)(P.ws + OFF_OD);
  const int stride = gridDim.x * 8;
  float4 lgv[4], lbv[4];
#pragma unroll
  for (int i = 0; i < 4; ++i) { lgv[i] = *(const float4*)(P.ln_g + lane * 4 + 256 * i); lbv[i] = *(const float4*)(P.ln_b + lane * 4 + 256 * i); }
  for (int row0 = blockIdx.x * 8 + w; row0 < NLAT; row0 += 4 * stride) {
    float v[4][16];
#pragma unroll
    for (int u = 0; u < 4; ++u) {
      const int row = (row0 + u * stride < NLAT) ? row0 + u * stride : row0;
      const float* xp = P.x + (size_t)row * 1024;
      const u16* gp = G + (size_t)row * 1024;
      const int n = row & 4095, pr = n >> 6, pc = n & 63;
#pragma unroll
      for (int i = 0; i < 4; ++i) {
        const int col = lane * 4 + 256 * i;
        const f32x4 a4 = __builtin_nontemporal_load((const f32x4*)(xp + col));
        const float4 a = {a4[0], a4[1], a4[2], a4[3]};
        const float4 q = *(const float4*)((col < 512) ? (POS + pr * 512 + col) : (POS + 32768 + pc * 512 + (col - 512)));
        const u32x2 g = __builtin_nontemporal_load((const u32x2*)(gp + col));
        v[u][4 * i] = (a.x + q.x) * 1.189207115002721f + bflo(g[0]);
        v[u][4 * i + 1] = (a.y + q.y) * 1.189207115002721f + bfhi(g[0]);
        v[u][4 * i + 2] = (a.z + q.z) * 1.189207115002721f + bflo(g[1]);
        v[u][4 * i + 3] = (a.w + q.w) * 1.189207115002721f + bfhi(g[1]);
      }
    }
#pragma unroll
    for (int u = 0; u < 4; ++u) {
      const int row = row0 + u * stride;
      float s = 0.f;
#pragma unroll
      for (int i = 0; i < 16; ++i) s += v[u][i];
      const float mean = wave_sum(s) * (1.f / 1024.f);
      float q = 0.f;
#pragma unroll
      for (int i = 0; i < 16; ++i) { const float d = v[u][i] - mean; q += d * d; }
      const float rstd = rsqrtf(wave_sum(q) * (1.f / 1024.f) + 1e-6f);
      if (row < NLAT) {
        float* p = P.out + (size_t)row * 1024;
#pragma unroll
        for (int i = 0; i < 4; ++i) {
          const int col = lane * 4 + 256 * i;
          const float4 g = lgv[i];
          const float4 bb = lbv[i];
          float4 o;
          o.x = (v[u][4 * i] - mean) * rstd * g.x + bb.x;
          o.y = (v[u][4 * i + 1] - mean) * rstd * g.y + bb.y;
          o.z = (v[u][4 * i + 2] - mean) * rstd * g.z + bb.z;
          o.w = (v[u][4 * i + 3] - mean) * rstd * g.w + bb.w;
          const f32x4 o4 = {o.x, o.y, o.z, o.w};
          __builtin_nontemporal_store(o4, (f32x4*)(p + col));
        }
      }
    }
  }
}

__global__ void __launch_bounds__(512, 2) fwd_megakernel(Params P0) {
  extern __shared__ __attribute__((aligned(16))) unsigned char dynsm[];
  char* smem = (char*)dynsm;
  cg::grid_group grid = cg::this_grid();
  volatile LAS unsigned* xb_st = (volatile LAS unsigned*)(dynsm + SMEM_BYTES);
  if (threadIdx.x == 0) { xb_st[0] = 0u; xb_st[1] = 0u; xb_st[2] = 0u; xb_st[3] = 0u; }
  __syncthreads();
  XcdBarrier xb = xcd_barrier_post((unsigned*)(P0.ws + OFF_BAR), xb_st);
  const Params& P = P0;
  u16* WT1 = (u16*)(P.ws + OFF_WT1);
  u16* H = (u16*)(P.ws + OFF_H);
  u16* GATES = (u16*)(P.ws + OFF_GATES);
  u16* YF = (u16*)P.out;
  for (int ph = P0.phase_lo; ph <= P0.phase_hi; ++ph) {
   for (int rep = 0; rep < ((ph == PROBE_DUP) ? 2 : 1); ++rep) {
    if (rep) xcd_barrier(xb);
    switch (ph) {
      case 0: phase_prep(P, smem, 0); break;
      case 1: phase_ln_mod(P); phase_prep(P, smem, 1); break;
      case 2: {
        EpiYT e1; e1.YT = (u16*)P.out;
        run_gemm(dynsm, WT1, H, 1024, NLAT, 1024, e1);
        EpiQKV e2; e2.QKV = (u16*)(P.ws + OFF_QKV); e2.BD = (float*)(P.ws + OFF_BD);
        run_gemm(dynsm, H, WT1 + (size_t)1024 * 1024, NROWS, 3328, 1024, e2);
      } break;
      case 3: phase_preadd(P); prep_segment(P, 0, smem, xb_st); break;
      case 4: {
        EpiDFT e; e.MIXED = (u16*)(P.ws + OFF_MIXED);
        run_gemm(dynsm, (const u16*)P.out + (size_t)4096 * 8192, (const u16*)P.out + (size_t)4096 * 8192 + (size_t)4096 * 4096, 4096, 4096, 4096, e);
      } break;
      case 14: {
        EpiGates e; e.GATES = GATES;
        run_gemm(dynsm, H, WT1 + (size_t)WT1_GATES_ROW * 1024, NLAT, 3584, 1024, e);
      } break;
      case 15: {
        phase_od(P);
        EpiGated e; e.OUT = (u16*)(P.ws + OFF_MG); e.ldo = 512; e.GATES = GATES; e.gcol0 = 0; e.ADD = nullptr;
        run_gemm(dynsm, (const u16*)(P.ws + OFF_MIXED), (const u16*)(P.ws + OFF_WFMIX), NLAT, 512, 512, e);
      } break;
      case 16: {
        {
          EpiGated e; e.OUT = YF; e.ldo = 1024; e.GATES = GATES; e.gcol0 = 1536; e.ADD = nullptr;
          run_gemm(dynsm, (const u16*)(P.ws + OFF_MG), (const u16*)(P.ws + OFF_WFOUT), NLAT, 1024, 512, e);
        }
        {
          EpiGated e; e.OUT = (u16*)(P.ws + OFF_MERGED); e.ldo = 1024; e.GATES = GATES; e.gcol0 = 2560; e.ADD = YF;
          run_gemm(dynsm, (const u16*)(P.ws + OFF_OD), (const u16*)(P.ws + OFF_WDN), NLAT, 1024, 1024, e);
        }
      } break;
      case 17: {
        EpiGateOut e; e.G = (u16*)(P.ws + OFF_OD); e.MOD = (const float*)(P.ws + OFF_MOD);
        run_gemm(dynsm, (const u16*)(P.ws + OFF_MERGED), (const u16*)(P.ws + OFF_WOUT), NLAT, 1024, 1024, e);
      } break;
      case 18: phase_final_ln(P); break;
      default: {
        const int seg = ph - 5;
        if (blockIdx.x < 128) scan_segment(P, seg, smem);
        if (seg < 8) {
          prep_segment(P, seg + 1, smem, xb_st);
        }
      } break;
    }
   }
    if (ph < P0.phase_hi) { if (ph >= 1000) grid.sync(); else xcd_barrier(xb); }
  }
}

extern "C" void kernel_launch(void* const* d_in, const int* in_sizes, int n_in, void* d_out, int out_size, void* d_ws,
                              size_t ws_size, hipStream_t stream) {
  (void)in_sizes; (void)n_in; (void)out_size;
  if (ws_size < WS_NEEDED) { fprintf(stderr, "workspace too small: %zu < %zu\n", ws_size, (size_t)WS_NEEDED); return; }
  static int grid_blocks = 0;
  if (!grid_blocks) {
    int dev = 0, cus = 0, per_cu = 0;
    (void)hipGetDevice(&dev);
    (void)hipDeviceGetAttribute(&cus, hipDeviceAttributeMultiprocessorCount, dev);
    if (hipFuncSetAttribute((const void*)fwd_megakernel, hipFuncAttributeMaxDynamicSharedMemorySize, SMEM_BYTES + 16) != hipSuccess)
      fprintf(stderr, "hipFuncSetAttribute(dynamic LDS %d) failed\n", SMEM_BYTES);
    (void)hipOccupancyMaxActiveBlocksPerMultiprocessor(&per_cu, fwd_megakernel, 512, SMEM_BYTES + 16);
    (void)hipGetLastError();
    grid_blocks = cus;
  }
  Params p{};
  p.x = (const float*)d_in[0]; p.c = (const float*)d_in[1]; p.ctx = (const float*)d_in[2]; p.c_ctx = (const float*)d_in[3];
  p.w_mod = (const float*)d_in[4]; p.b_mod = (const float*)d_in[5]; p.w_in = (const float*)d_in[6];
  p.conv_w = (const float*)d_in[7]; p.a_log = (const float*)d_in[8]; p.dt_bias = (const float*)d_in[9];
  p.dn_norm_w = (const float*)d_in[10]; p.w_dn_out = (const float*)d_in[11]; p.w_fmix = (const float*)d_in[12];
  p.w_f_out = (const float*)d_in[13]; p.w_out = (const float*)d_in[14]; p.ln_g = (const float*)d_in[15];
  p.ln_b = (const float*)d_in[16];
  p.out = (float*)d_out;
  p.ws = (char*)d_ws;
  (void)hipMemsetAsync((char*)d_ws + OFF_BAR, 0, 32768, stream);
#if MK_MULTI
  for (int ph = 0; ph < NPHASE; ++ph) {
    p.phase_lo = ph; p.phase_hi = ph;
    hipLaunchKernelGGL(fwd_megakernel, dim3(grid_blocks), dim3(512), SMEM_BYTES + 16, stream, p);
  }
#else
  p.phase_lo = 0; p.phase_hi = NPHASE - 1;
  void* args[] = {&p};
  hipError_t e = hipLaunchCooperativeKernel((void*)fwd_megakernel, dim3(grid_blocks), dim3(512), args, SMEM_BYTES + 16, stream);
  if (e != hipSuccess) fprintf(stderr, "cooperative launch failed: %s (grid %d)\n", hipGetErrorString(e), grid_blocks);
#endif
}
```
